# Optimizing an MI355X kernel written in HIP

```python
import jax
import jax.numpy as jnp
from jax import lax
import numpy as np

D_MODEL = 1024
BATCH = 8
SEQ = 2048
DEPTH = 2
DEC_BATCH = 128
DEC_SEQ = 4
PAST_LEN = 16384
PAGE_SIZE = 128

N_EVEN = (DEPTH + 1) // 2
N_ODD = DEPTH // 2
N_SUB = 3
EPS = 1e-6
A_HEADS = 8
A_KV_HEADS = 2
A_HEAD_DIM = 64
A_GROUP = A_HEADS // A_KV_HEADS
WINDOW = 128
ROPE_THETA = 500000.0
ROT_DIM = A_HEAD_DIM // 4
B_WIDTH = D_MODEL // 2
B_BLOCKS = 8
B_BLOCK_DIM = B_WIDTH // B_BLOCKS
CONV_W = 4
RG_C = 8.0
C_HEADS = 8
C_KEY_DIM = D_MODEL // C_HEADS
C_VAL_DIM = D_MODEL // C_HEADS
C_CHUNK = 32
D_FF = ((8 * D_MODEL // 3 + 127) // 128) * 128
A_Q = A_HEADS * A_HEAD_DIM
A_KV = A_KV_HEADS * A_HEAD_DIM
EVEN_IN = A_Q + 2 * A_KV + 2 * B_WIDTH
EVEN_MIX = A_Q + B_WIDTH
C_HK = C_HEADS * C_KEY_DIM
ODD_MIX = C_HEADS * C_VAL_DIM
ODD_IN = 2 * C_HK + 2 * ODD_MIX

kernel_name = 'hybrid_swa_rglru_hgrn2_macaron_step'


def _rms_norm(x, gain):
    xf = x.astype(jnp.float32)
    inv = lax.rsqrt(jnp.mean(xf * xf, axis=-1, keepdims=True) + EPS)
    return (xf * inv).astype(x.dtype) * gain.astype(x.dtype)


def _pre(x, c, g_pre, ada_w, ada_b):
    mod = jax.nn.silu(c) @ ada_w + ada_b
    shift, scale, gate = jnp.split(mod[:, None, :], 3, axis=-1)
    return _rms_norm(x, g_pre) * (1 + scale) + shift, gate


def _post(x, y, gate, g_post, res_w):
    return x + res_w * (1 + gate) * _rms_norm(y, g_post)


def _swiglu(h, w_in, w_out):
    g, u = jnp.split(h @ w_in, 2, axis=-1)
    return (jax.nn.silu(g) * u) @ w_out


def _rope_partial(x, pos):
    inv_freq = ROPE_THETA ** (-jnp.arange(0, ROT_DIM, 2, dtype=jnp.float32) / ROT_DIM)
    ang = pos.astype(jnp.float32)[:, None] * inv_freq[None, :]
    cos = jnp.cos(ang)[None, :, None, :]
    sin = jnp.sin(ang)[None, :, None, :]
    half = ROT_DIM // 2
    x1 = x[..., :half].astype(jnp.float32)
    x2 = x[..., half:ROT_DIM].astype(jnp.float32)
    rot = jnp.concatenate([x1 * cos - x2 * sin, x2 * cos + x1 * sin], axis=-1).astype(x.dtype)
    return jnp.concatenate([rot, x[..., ROT_DIM:]], axis=-1)


def _sink_attention(q, k, v, q_pos, k_pos, sinks):
    B, N, Tq, H, Dh = q.shape
    qg = q.reshape(B, N, Tq, A_KV_HEADS, A_GROUP, Dh)
    s = jnp.einsum('bnqkgd,bnskd->bnkgqs', qg, k).astype(jnp.float32) / np.float32(np.sqrt(Dh))
    rel = q_pos[:, :, None] - k_pos[:, None, :]
    mask = (rel >= 0) & (rel < WINDOW) & (k_pos[:, None, :] >= 0)
    s = jnp.where(mask[None, :, None, None], s, -jnp.inf)
    sink = jnp.broadcast_to(sinks.astype(jnp.float32).reshape(1, 1, A_KV_HEADS, A_GROUP, 1, 1), s.shape[:-1] + (1,))
    p = jax.nn.softmax(jnp.concatenate([s, sink], axis=-1), axis=-1)[..., :-1].astype(v.dtype)
    o = jnp.einsum('bnkgqs,bnskd->bnqkgd', p, v)
    return o.reshape(B, N, Tq, H, Dh)


def _swa_prompt(q, k, v, sinks):
    B, T, H, Dh = q.shape
    N = T // WINDOW
    qb = q.reshape(B, N, WINDOW, H, Dh)
    kb = k.reshape(B, N, WINDOW, A_KV_HEADS, Dh)
    vb = v.reshape(B, N, WINDOW, A_KV_HEADS, Dh)
    prev = lambda a: jnp.pad(a, ((0, 0), (1, 0), (0, 0), (0, 0), (0, 0)))[:, :-1]
    kk = jnp.concatenate([prev(kb), kb], axis=2)
    vv = jnp.concatenate([prev(vb), vb], axis=2)
    pos = jnp.arange(T, dtype=jnp.int32).reshape(N, WINDOW)
    k_pos = jnp.concatenate([pos - WINDOW, pos], axis=1)
    return _sink_attention(qb, kk, vv, pos, k_pos, sinks).reshape(B, T, H, Dh)


def _swa_sample(q, k, v, prefix_k, prefix_v, pos0, sinks):
    B, T, H, Dh = q.shape
    P = prefix_k.shape[1]
    kk = jnp.concatenate([prefix_k.astype(k.dtype), k], axis=1)
    vv = jnp.concatenate([prefix_v.astype(v.dtype), v], axis=1)
    q_pos = pos0 + jnp.arange(T, dtype=jnp.int32)
    k_pos = jnp.concatenate([pos0 - P + jnp.arange(P, dtype=jnp.int32), q_pos])
    o = _sink_attention(q[:, None], kk[:, None], vv[:, None], q_pos[None], k_pos[None], sinks)
    return o[:, 0], kk[:, -P:], vv[:, -P:]


def _lin_combine(left, right):
    a1, b1 = left
    a2, b2 = right
    return a1 * a2, a2 * b1 + b2


def _rglru_branch(xr, conv_buf, h0, conv_w, conv_b, wa, ba, wx, bx, lam):
    B, T, W = xr.shape
    xp = jnp.concatenate([conv_buf.astype(xr.dtype), xr], axis=1)
    xc = conv_b
    for j in range(CONV_W):
        xc = xc + xp[:, j:j + T] * conv_w[j]
    new_buf = xp[:, T:]
    xb = xc.reshape(B, T, B_BLOCKS, B_BLOCK_DIM)
    r = jax.nn.sigmoid(jnp.einsum('btkd,kde->btke', xb, wa).reshape(B, T, W) + ba)
    i = jax.nn.sigmoid(jnp.einsum('btkd,kde->btke', xb, wx).reshape(B, T, W) + bx)
    log_a = -RG_C * r.astype(jnp.float32) * jax.nn.softplus(-lam.astype(jnp.float32))
    a = jnp.exp(log_a)
    mult = jnp.sqrt(jnp.maximum(1.0 - jnp.exp(2.0 * log_a), 0.0))
    b = mult * (i * xc).astype(jnp.float32)
    b = b.at[:, 0].add(a[:, 0] * h0.astype(jnp.float32))
    _, hs = lax.associative_scan(_lin_combine, (a, b), axis=1)
    return hs.astype(xr.dtype), new_buf, hs[:, -1]


def _even_mixer(h, pos0, prefix_k, prefix_v, conv_buf, h0, w_in, w_out, sinks,
                conv_w, conv_b, wa, ba, wx, bx, lam):
    B, T, _ = h.shape
    q, k, v, xg, xr = jnp.split(h @ w_in, [A_Q, A_Q + A_KV, A_Q + 2 * A_KV, A_Q + 2 * A_KV + B_WIDTH], axis=-1)
    pos = pos0 + jnp.arange(T, dtype=jnp.int32)
    q = _rope_partial(q.reshape(B, T, A_HEADS, A_HEAD_DIM), pos)
    k = _rope_partial(k.reshape(B, T, A_KV_HEADS, A_HEAD_DIM), pos)
    v = v.reshape(B, T, A_KV_HEADS, A_HEAD_DIM)
    if prefix_k is None:
        o_a = _swa_prompt(q, k, v, sinks)
        win = min(WINDOW, PAST_LEN)
        k_win, v_win = k[:, -win:], v[:, -win:]
    else:
        o_a, k_win, v_win = _swa_sample(q, k, v, prefix_k, prefix_v, pos0, sinks)
    o_b, new_buf, h_last = _rglru_branch(xr, conv_buf, h0, conv_w, conv_b, wa, ba, wx, bx, lam)
    o_b = jax.nn.gelu(xg, approximate=True) * o_b
    y = jnp.concatenate([o_a.reshape(B, T, A_Q), o_b], axis=-1) @ w_out
    return y, k_win, v_win, new_buf, h_last


def _hgrn2_chunked(q, log_f, k, v, s0):
    B, T, H, K = q.shape
    V = v.shape[-1]
    L = min(C_CHUNK, T)
    N = -(-T // L)
    pad = N * L - T

    def chunks(a):
        a = jnp.pad(a.astype(jnp.float32), ((0, 0), (0, pad), (0, 0), (0, 0)))
        return jnp.moveaxis(a.reshape(B, N, L, H, a.shape[-1]), 1, 0)

    qc, kc, vc = chunks(q), chunks(k), chunks(v)
    bc = jnp.cumsum(chunks(log_f), axis=2)
    causal = jnp.tril(jnp.ones((L, L), dtype=bool))[None, :, :, None, None]

    def step(S, xs):
        qi, ki, vi, bi = xs
        diff = bi[:, :, None] - bi[:, None, :]
        dec = jnp.where(causal, jnp.exp(jnp.minimum(diff, 0.0)), 0.0)
        scores = jnp.einsum('bthk,bshk,btshk->bhts', qi, ki, dec)
        o = jnp.einsum('bhts,bshv->bthv', scores, vi) + jnp.einsum('bthk,bhkv->bthv', qi * jnp.exp(bi), S)
        b_last = bi[:, -1]
        S_new = jnp.exp(b_last)[..., None] * S + jnp.einsum('bshk,bshv->bhkv', ki * jnp.exp(b_last[:, None] - bi), vi)
        return S_new, o

    s_last, o = lax.scan(step, s0.astype(jnp.float32), (qc, kc, vc, bc))
    o = jnp.moveaxis(o, 0, 1).reshape(B, N * L, H, V)[:, :T]
    return o, s_last


def _lower_bound(lb_logits, layer):
    gam = jax.nn.softmax(lb_logits.astype(jnp.float32), axis=0)
    return jnp.cumsum(gam, axis=0)[layer] - gam[0]


def _odd_mixer(h, s0, lb, w_in, w_out, gnorm):
    B, T, _ = h.shape
    q, fz, v, g = jnp.split(h @ w_in, [C_HK, 2 * C_HK, 2 * C_HK + ODD_MIX], axis=-1)
    f = lb + (1.0 - lb) * jax.nn.sigmoid(fz.astype(jnp.float32))
    shp = (B, T, C_HEADS, C_KEY_DIM)
    o, s_last = _hgrn2_chunked(q.reshape(shp), jnp.log(f).reshape(shp), (1.0 - f).reshape(shp),
                               v.reshape(B, T, C_HEADS, C_VAL_DIM), s0)
    o = _rms_norm(o, gnorm) * jax.nn.silu(g.reshape(B, T, C_HEADS, C_VAL_DIM).astype(jnp.float32))
    y = o.reshape(B, T, ODD_MIX).astype(h.dtype) @ w_out
    return y, s_last


def _trunk(x, c, pos0, k_win, v_win, conv_st, h_st, s_st, W):
    B = x.shape[0]
    new_k, new_v, new_conv, new_h, new_s = [], [], [], [], []
    for l in range(DEPTH):
        h, gate = _pre(x, c, W['norm_pre'][l, 0], W['ada_w'][l, 0], W['ada_b'][l, 0])
        x = _post(x, _swiglu(h, W['ffn1_w_in'][l], W['ffn1_w_out'][l]), gate, W['norm_post'][l, 0], 0.5)
        h, gate = _pre(x, c, W['norm_pre'][l, 1], W['ada_w'][l, 1], W['ada_b'][l, 1])
        if l % 2 == 0:
            e = l // 2
            if k_win is None:
                pk, pv = None, None
                cb = jnp.zeros((B, CONV_W - 1, B_WIDTH), x.dtype)
                h0 = jnp.zeros((B, B_WIDTH), jnp.float32)
            else:
                pk, pv, cb, h0 = k_win[e], v_win[e], conv_st[e], h_st[e]
            y, kw, vw, cbn, hl = _even_mixer(h, pos0, pk, pv, cb, h0, W['even_w_in'][e], W['even_w_out'][e],
                                            W['attn_sinks'][e], W['rg_conv_w'][e], W['rg_conv_b'][e],
                                            W['rg_wa'][e], W['rg_ba'][e], W['rg_wx'][e], W['rg_bx'][e],
                                            W['rg_lambda'][e])
            new_k.append(kw)
            new_v.append(vw)
            new_conv.append(cbn)
            new_h.append(hl)
        else:
            o = l // 2
            s0 = jnp.zeros((B, C_HEADS, C_KEY_DIM, C_VAL_DIM), jnp.float32) if s_st is None else s_st[o]
            lb = _lower_bound(W['hgrn_lb_logits'], l)
            y, sl = _odd_mixer(h, s0, lb, W['odd_w_in'][o], W['odd_w_out'][o], W['hgrn_gnorm'][o])
            new_s.append(sl)
        x = _post(x, y, gate, W['norm_post'][l, 1], 1.0)
        h, gate = _pre(x, c, W['norm_pre'][l, 2], W['ada_w'][l, 2], W['ada_b'][l, 2])
        x = _post(x, _swiglu(h, W['ffn2_w_in'][l], W['ffn2_w_out'][l]), gate, W['norm_post'][l, 2], 0.5)
    return (x, jnp.stack(new_k), jnp.stack(new_v), jnp.stack(new_conv), jnp.stack(new_h), jnp.stack(new_s))


def setup_inputs(seed: int = 0) -> dict:
    key = jax.random.key(seed)
    ks = iter(jax.random.split(key, 48))
    nrm = lambda shape, scale: scale * jax.random.normal(next(ks), shape, jnp.float32)
    win = min(WINDOW, PAST_LEN)
    D = D_MODEL
    a0 = jax.random.uniform(next(ks), (N_EVEN, B_WIDTH), jnp.float32, minval=0.9, maxval=0.999)
    s_a = a0 ** (1.0 / RG_C)
    rg_lambda = jnp.log(s_a) - jnp.log1p(-s_a)
    return {
        'x_prompt': nrm((BATCH, SEQ, D), 1.0),
        'x_sample': nrm((DEC_BATCH, DEC_SEQ, D), 1.0),
        'c_prompt': nrm((BATCH, D), 1.0),
        'c_sample': nrm((DEC_BATCH, D), 1.0),
        'cache_k_win': nrm((N_EVEN, DEC_BATCH, win, A_KV_HEADS, A_HEAD_DIM), 1.0),
        'cache_v_win': nrm((N_EVEN, DEC_BATCH, win, A_KV_HEADS, A_HEAD_DIM), 1.0),
        'state_conv_rglru': nrm((N_EVEN, DEC_BATCH, CONV_W - 1, B_WIDTH), 1.0),
        'state_h_rglru': nrm((N_EVEN, DEC_BATCH, B_WIDTH), 0.5),
        'state_s_hgrn': nrm((N_ODD, DEC_BATCH, C_HEADS, C_KEY_DIM, C_VAL_DIM), 0.5),
        'norm_pre': 1.0 + nrm((DEPTH, N_SUB, D), 0.05),
        'norm_post': 1.0 + nrm((DEPTH, N_SUB, D), 0.05),
        'ada_w': nrm((DEPTH, N_SUB, D, 3 * D), 0.2 * D ** -0.5),
        'ada_b': nrm((DEPTH, N_SUB, 3 * D), 0.01),
        'ffn1_w_in': nrm((DEPTH, D, 2 * D_FF), D ** -0.5),
        'ffn1_w_out': nrm((DEPTH, D_FF, D), D_FF ** -0.5),
        'ffn2_w_in': nrm((DEPTH, D, 2 * D_FF), D ** -0.5),
        'ffn2_w_out': nrm((DEPTH, D_FF, D), D_FF ** -0.5),
        'even_w_in': nrm((N_EVEN, D, EVEN_IN), D ** -0.5),
        'even_w_out': nrm((N_EVEN, EVEN_MIX, D), EVEN_MIX ** -0.5),
        'attn_sinks': nrm((N_EVEN, A_HEADS), 1.0),
        'rg_conv_w': nrm((N_EVEN, CONV_W, B_WIDTH), CONV_W ** -0.5),
        'rg_conv_b': nrm((N_EVEN, B_WIDTH), 0.01),
        'rg_wa': nrm((N_EVEN, B_BLOCKS, B_BLOCK_DIM, B_BLOCK_DIM), B_BLOCK_DIM ** -0.5),
        'rg_ba': nrm((N_EVEN, B_WIDTH), 0.01),
        'rg_wx': nrm((N_EVEN, B_BLOCKS, B_BLOCK_DIM, B_BLOCK_DIM), B_BLOCK_DIM ** -0.5),
        'rg_bx': nrm((N_EVEN, B_WIDTH), 0.01),
        'rg_lambda': rg_lambda,
        'odd_w_in': nrm((N_ODD, D, ODD_IN), D ** -0.5),
        'odd_w_out': nrm((N_ODD, ODD_MIX, D), ODD_MIX ** -0.5),
        'hgrn_lb_logits': nrm((DEPTH, C_HK), 0.5),
        'hgrn_gnorm': 1.0 + nrm((N_ODD, C_VAL_DIM), 0.05),
    }


def reference(x_prompt, x_sample, c_prompt, c_sample, cache_k_win, cache_v_win, state_conv_rglru,
              state_h_rglru, state_s_hgrn, norm_pre, norm_post, ada_w, ada_b, ffn1_w_in, ffn1_w_out,
              ffn2_w_in, ffn2_w_out, even_w_in, even_w_out, attn_sinks, rg_conv_w, rg_conv_b, rg_wa,
              rg_ba, rg_wx, rg_bx, rg_lambda, odd_w_in, odd_w_out, hgrn_lb_logits, hgrn_gnorm):
    W = dict(norm_pre=norm_pre, norm_post=norm_post, ada_w=ada_w, ada_b=ada_b,
             ffn1_w_in=ffn1_w_in, ffn1_w_out=ffn1_w_out, ffn2_w_in=ffn2_w_in, ffn2_w_out=ffn2_w_out,
             even_w_in=even_w_in, even_w_out=even_w_out, attn_sinks=attn_sinks,
             rg_conv_w=rg_conv_w, rg_conv_b=rg_conv_b, rg_wa=rg_wa, rg_ba=rg_ba, rg_wx=rg_wx,
             rg_bx=rg_bx, rg_lambda=rg_lambda, odd_w_in=odd_w_in, odd_w_out=odd_w_out,
             hgrn_lb_logits=hgrn_lb_logits, hgrn_gnorm=hgrn_gnorm)
    y_prompt, k_win_p, v_win_p, conv_p, h_p, s_p = _trunk(x_prompt, c_prompt, 0, None, None, None, None, None, W)
    y_sample, k_win_s, v_win_s, conv_s, h_s, s_s = _trunk(x_sample, c_sample, PAST_LEN, cache_k_win, cache_v_win,
                                                         state_conv_rglru, state_h_rglru, state_s_hgrn, W)
    return (y_prompt, y_sample, k_win_p, v_win_p, conv_p, h_p, s_p, k_win_s, v_win_s, conv_s, h_s, s_s)
```

```cpp
#include <hip/hip_runtime.h>
#include <hip/hip_cooperative_groups.h>
#include <cstdio>
namespace cg = cooperative_groups;
__device__ __forceinline__ int tidx() { int t = threadIdx.x; asm volatile("" : "+v"(t)); return t; }
namespace pg8 {
#define PG8_LAS __attribute__((address_space(3)))
typedef unsigned short bf16_t;
typedef short bf16x8 __attribute__((ext_vector_type(8)));
typedef float f32x4 __attribute__((ext_vector_type(4)));
typedef unsigned u32x4 __attribute__((ext_vector_type(4)));
constexpr int BM = 256, BK = 64, HALF = 128, HTB = HALF * BK * 2  , STAGE_BYTES = 8 * HTB, NXCD = 8, WGM = 8;

__host__ __device__ __forceinline__ int lds_byte(int r, int c) { const int st = (r >> 4) * 2 + (c >> 5), rr = r & 15, cc = c & 31, ob = rr * 64 + cc * 2; return st * 1024 + (ob ^ (((ob >> 9) & 1) << 5)); }
__host__ __device__ __forceinline__ void stage_rc(int b, int& R, int& C) { const int st = b / 1024, sb = b % 1024, swz = sb ^ (((sb >> 9) & 1) << 5); R = (st >> 1) * 16 + swz / 64; C = (st & 1) * 32 + (swz % 64) / 2; }
__host__ __device__ __forceinline__ int perm32(int rho) { const int n = rho >> 4, i = rho & 15; return 8 * (i >> 2) + 4 * n + (i & 3); }

struct Unit { int pm, pn; };
struct Gemm { const bf16_t* A; const bf16_t* Bt; int M, N, K; };

struct StaticOrder {
    int nM, nN, nwg, G, c;
    __host__ __device__ void init(int M, int N, int G_, int c_) { nM = M / BM; nN = N / BM; nwg = nM * nN; G = G_; c = c_; }
    __host__ __device__ bool next(int i, Unit& u) const {
        const long L = (long)i * G + c; if (L >= nwg) return false;
        int wgid = (int)L; { const int q = nwg / NXCD, r = nwg % NXCD, xcd = wgid % NXCD, off = wgid / NXCD; wgid = (xcd < r ? xcd * (q + 1) : r * (q + 1) + (xcd - r) * q) + off; }
        const int nig = WGM * nN, gid = wgid / nig, fm = gid * WGM, gsz = (nM - fm) < WGM ? (nM - fm) : WGM;
        u.pm = fm + ((wgid % nig) % gsz); u.pn = (wgid % nig) / gsz; return true;
    }
    __device__ __forceinline__ void a_ready(const Unit&) const {}
    __device__ __forceinline__ void done(const Unit&) const {}
};
__device__ __forceinline__ unsigned cvt_pk_bf16(float lo, float hi) { unsigned r; asm volatile("v_cvt_pk_bf16_f32 %0, %1, %2" : "=v"(r) : "v"(lo), "v"(hi)); return r; }
template <class Epi, class Sched, bool STAMP = false>
__device__ __forceinline__ void gemm_phase(PG8_LAS unsigned char* lds, const Gemm g, const Sched& S, const Epi& E, unsigned long long* stamps) {
    const int tid = tidx(), wid = __builtin_amdgcn_readfirstlane(tid >> 6), lane = tid & 63, wr = wid >> 2, wc = wid & 3, fr = lane & 15, fq = lane >> 4;
    const int K = g.K, nt = K / BK;
    int ts_lo = 0, ts_hi = 0, nts = 0; const unsigned long long rt_entry = STAMP ? (unsigned long long)wall_clock64() : 0ull;
#define PG8_STAMP() do { if (STAMP && wid == 0 && nts < 64) { const unsigned long long _c = (unsigned long long)clock64(); \
        ts_lo = (lane == nts) ? (int)(unsigned)_c : ts_lo; ts_hi = (lane == nts) ? (int)(unsigned)(_c >> 32) : ts_hi; ++nts; } } while (0)
    PG8_STAMP();
    unsigned voffA[2], voffB[2];
#pragma unroll
    for (int i = 0; i < 2; ++i) { int R, C; stage_rc(tid * 16 + i * 8192, R, C); const int Rb = Epi::PERM ? ((R & ~31) + perm32(R & 31)) : R;
        voffA[i] = (unsigned)(R * K + C) * 2u; voffB[i] = (unsigned)(Rb * K + C) * 2u; }
    const size_t kstep = (size_t)(BK * 2);
    const size_t hstep = (size_t)HALF * K * 2;
    const size_t tstep = 2 * hstep;
    const unsigned ldsw = (unsigned)wid * 1024u;
    const int aoff = lds_byte(wr * 64 + fr, fq * 8), boff = lds_byte(wc * 32 + fr, fq * 8);
#define PG8_SA(b, h) (((b) * 2 + (h)) * HTB)
#define PG8_SB(b, h) ((4 + (b) * 2 + (h)) * HTB)
#define PG8_STAGE(bufoff, gbase, voff) do { _Pragma("unroll") for (int _i = 0; _i < 2; ++_i) \
        __builtin_amdgcn_global_load_lds((const unsigned*)((const char*)(gbase) + (voff)[_i]), (PG8_LAS unsigned*)(lds + (bufoff) + ldsw + _i * 8192), 16, 0, 0); } while (0)
#define PG8_LDA(dst, b, h) do { _Pragma("unroll") for (int m = 0; m < 4; ++m) _Pragma("unroll") for (int k = 0; k < 2; ++k) dst[m][k] = *(const PG8_LAS bf16x8*)(lds + PG8_SA(b, h) + aoff + m * 2048 + k * 1024); } while (0)
#define PG8_LDB(dst, b, h) do { _Pragma("unroll") for (int n = 0; n < 2; ++n) _Pragma("unroll") for (int k = 0; k < 2; ++k) dst[n][k] = *(const PG8_LAS bf16x8*)(lds + PG8_SB(b, h) + boff + n * 2048 + k * 1024); } while (0)
#define PG8_MMA(ai, bj, At, Bt) do { __builtin_amdgcn_s_setprio(1); _Pragma("unroll") for (int m = 0; m < 4; ++m) _Pragma("unroll") for (int n = 0; n < 2; ++n) _Pragma("unroll") for (int k = 0; k < 2; ++k) \
        acc[ai][bj][m][n] = __builtin_amdgcn_mfma_f32_16x16x32_bf16(Bt[n][k], At[m][k], acc[ai][bj][m][n], 0, 0, 0); __builtin_amdgcn_s_setprio(0); } while (0)
#define PG8_WAIT_V(n) asm volatile("s_waitcnt vmcnt(" #n ")" ::: "memory")
#define PG8_WAIT_L(n) asm volatile("s_waitcnt lgkmcnt(" #n ")" ::: "memory")
#define PG8_BAR __builtin_amdgcn_s_barrier()
#define PG8_SCHED __builtin_amdgcn_sched_barrier(0)
    Unit cur, nxt; int ui = 0;
    if (!S.next(0, cur)) return;
    f32x4 acc[2][2][4][2];
#pragma unroll
    for (int a = 0; a < 2; ++a)
#pragma unroll
        for (int b = 0; b < 2; ++b)
#pragma unroll
            for (int m = 0; m < 4; ++m)
#pragma unroll
                for (int n = 0; n < 2; ++n) acc[a][b][m][n] = (f32x4){0.f, 0.f, 0.f, 0.f};
    bf16x8 At[4][2], B0[2][2], B1[2][2];
    const char* cA = (const char*)g.A + (size_t)cur.pm * tstep; const char* cB = (const char*)g.Bt + (size_t)cur.pn * tstep;
    S.a_ready(cur);
    PG8_STAGE(PG8_SB(0, 0), cB, voffB); PG8_STAGE(PG8_SA(0, 0), cA, voffA); PG8_STAGE(PG8_SB(0, 1), cB + hstep, voffB); PG8_STAGE(PG8_SA(0, 1), cA + hstep, voffA);
    if (wr == 1) PG8_BAR;
    PG8_WAIT_V(4); PG8_BAR;
    PG8_STAGE(PG8_SB(1, 0), cB + kstep, voffB); PG8_STAGE(PG8_SA(1, 0), cA + kstep, voffA); PG8_STAGE(PG8_SB(1, 1), cB + hstep + kstep, voffB);
    PG8_WAIT_V(6); PG8_BAR;
    PG8_STAMP();
    for (;;) {
        const bool has_next = S.next(ui + 1, nxt);
        const char* nA = has_next ? (const char*)g.A + (size_t)nxt.pm * tstep : cA; const char* nB = has_next ? (const char*)g.Bt + (size_t)nxt.pn * tstep : cB;
        for (int t = 0; t < nt; t += 2) {
            const bool last = (t == nt - 2);
            const char* a1 = cA + (size_t)(t + 1) * kstep;
            const char* a2 = last ? nA : cA + (size_t)(t + 2) * kstep; const char* b2 = last ? nB : cB + (size_t)(t + 2) * kstep;
            const char* a3 = a2 + kstep; const char* b3 = b2 + kstep;
            if (last && has_next) S.a_ready(nxt);
            PG8_LDB(B0, 0, 0); PG8_SCHED; PG8_LDA(At, 0, 0); PG8_STAGE(PG8_SA(1, 1), a1 + hstep, voffA);
            PG8_WAIT_L(8); PG8_BAR; PG8_WAIT_L(0); PG8_MMA(0, 0, At, B0); PG8_BAR; PG8_SCHED;
            PG8_LDB(B1, 0, 1); PG8_STAGE(PG8_SB(0, 0), b2, voffB);
            PG8_BAR; PG8_WAIT_L(0); PG8_MMA(0, 1, At, B1); PG8_BAR;
            PG8_LDA(At, 0, 1); PG8_STAGE(PG8_SA(0, 0), a2, voffA);
            PG8_BAR; PG8_WAIT_L(0); PG8_MMA(1, 0, At, B0); PG8_BAR; PG8_SCHED;
            PG8_STAGE(PG8_SB(0, 1), b2 + hstep, voffB);
            PG8_WAIT_V(6); PG8_BAR; PG8_MMA(1, 1, At, B1); PG8_BAR;
            PG8_LDB(B0, 1, 0); PG8_SCHED; PG8_LDA(At, 1, 0); PG8_STAGE(PG8_SA(0, 1), a2 + hstep, voffA);
            PG8_WAIT_L(8); PG8_BAR; PG8_WAIT_L(0); PG8_MMA(0, 0, At, B0); PG8_BAR; PG8_SCHED;
            PG8_LDB(B1, 1, 1); PG8_STAGE(PG8_SB(1, 0), b3, voffB);
            PG8_BAR; PG8_WAIT_L(0); PG8_MMA(0, 1, At, B1); PG8_BAR;
            PG8_LDA(At, 1, 1); PG8_STAGE(PG8_SA(1, 0), a3, voffA);
            PG8_BAR; PG8_WAIT_L(0); PG8_MMA(1, 0, At, B0); PG8_BAR; PG8_SCHED;
            PG8_STAGE(PG8_SB(1, 1), b3 + hstep, voffB);
            PG8_WAIT_V(6); PG8_BAR; PG8_MMA(1, 1, At, B1); PG8_BAR;
        }
        PG8_STAMP();
        if constexpr (!Epi::AFTER_DRAIN) { E(acc, cur, wr, wc, fr, fq); S.done(cur); }
        PG8_STAMP();
        if (!has_next) break;
#pragma unroll
        for (int a = 0; a < 2; ++a)
#pragma unroll
            for (int b = 0; b < 2; ++b)
#pragma unroll
                for (int m = 0; m < 4; ++m)
#pragma unroll
                    for (int n = 0; n < 2; ++n) acc[a][b][m][n] = (f32x4){0.f, 0.f, 0.f, 0.f};
        cur = nxt; cA = nA; cB = nB; ++ui;
    }
    PG8_WAIT_V(0);
    if (wr == 0) PG8_BAR;
    PG8_BAR;
    if constexpr (Epi::AFTER_DRAIN) { E.fused(acc, cur, wr, wc, fr, fq, lds, wid, lane); S.done(cur); }
    PG8_STAMP();
    if (STAMP && wid == 0) { stamps[lane] = lane < nts ? (((unsigned long long)(unsigned)ts_hi << 32) | (unsigned)ts_lo) : 0ull;
        if (lane == 62) stamps[62] = rt_entry; if (lane == 63) stamps[63] = (unsigned long long)wall_clock64(); }
#undef PG8_STAMP
#undef PG8_SA
#undef PG8_SB
#undef PG8_STAGE
#undef PG8_LDA
#undef PG8_LDB
#undef PG8_MMA
#undef PG8_WAIT_V
#undef PG8_WAIT_L
#undef PG8_BAR
#undef PG8_SCHED
}
}

using pg8::bf16_t; using pg8::bf16x8; using pg8::f32x4; using pg8::u32x4; using pg8::Unit; using pg8::cvt_pk_bf16;
typedef unsigned u32x2 __attribute__((ext_vector_type(2)));

constexpr int TP = 16384, TT = 16896, NMOD = 18432;
enum { I_XP = 0, I_XS, I_CP, I_CS, I_CK, I_CV, I_SCONV, I_SH, I_SS, I_NPRE, I_NPOST, I_ADAW, I_ADAB, I_F1IN, I_F1OUT, I_F2IN, I_F2OUT,
       I_EIN, I_EOUT, I_SINK, I_CONVW, I_CONVB, I_WA, I_BA, I_WX, I_BX, I_LAM, I_OIN, I_OOUT, I_LB, I_GN, N_INPUTS };
constexpr size_t O_KWP = 17301504, O_VWP = O_KWP + 131072, O_CONVP = O_VWP + 131072, O_HP = O_CONVP + 12288, O_SP = O_HP + 4096,
                 O_KWS = O_SP + 1048576, O_VWS = O_KWS + 2097152, O_CONVS = O_VWS + 2097152, O_HS = O_CONVS + 196608, O_SS = O_HS + 65536;
constexpr size_t SZ_FIN = 5632ull * 1024 * 2, SZ_FOUT = 1024ull * 2816 * 2;
constexpr size_t WS_FIN = 0, WS_FOUT = WS_FIN + 4 * SZ_FIN, WS_EIN = WS_FOUT + 4 * SZ_FOUT, WS_EOUT = WS_EIN + 1792ull * 1024 * 2,
                 WS_OIN = WS_EOUT + 1024ull * 1024 * 2, WS_OOUT = WS_OIN + 4096ull * 1024 * 2, WS_ADA = WS_OOUT + 1024ull * 1024 * 2,
                 WS_AADA = WS_ADA + 18432ull * 1024 * 2, WS_MOD = WS_AADA + 256ull * 1024 * 2, WS_ROPE = WS_MOD + 256ull * 18432 * 4,
                 WS_H = WS_ROPE + 2052ull * 16 * 4, WS_A2 = WS_H + 16896ull * 1024 * 2, WS_Y = WS_A2 + 16896ull * 2816 * 2,
                 WS_END = WS_Y + 16896ull * 1024 * 4;
constexpr size_t WS_QKV = WS_A2, WS_XGR = WS_A2 + 16896ull * 768 * 2, WS_LA = WS_Y, WS_LB = WS_Y + 16896ull * 512 * 4, WS_Z = WS_H, WS_QFVG = WS_A2;
constexpr int LDS_BYTES = 147456;

struct Params { const float* in[N_INPUTS]; float* out; unsigned char* ws; int ph_lo, ph_hi; };
typedef const __attribute__((address_space(4))) Params* KP;

__device__ __forceinline__ float bf_lo(unsigned u) { return __uint_as_float(u << 16); }
__device__ __forceinline__ float bf_hi(unsigned u) { return __uint_as_float(u & 0xffff0000u); }
__device__ __forceinline__ float bf1(bf16_t u) { return __uint_as_float(((unsigned)u) << 16); }
__device__ __forceinline__ bf16_t f2bf(float f) { return (bf16_t)(cvt_pk_bf16(f, 0.f) & 0xffffu); }
__device__ __forceinline__ float sigmoidf_(float x) { return 1.f / (1.f + __expf(-x)); }
__device__ __forceinline__ float siluf_(float x) { return x / (1.f + __expf(-x)); }
__device__ __forceinline__ float wave_sum(float v) {
#pragma unroll
    for (int o = 32; o > 0; o >>= 1) v += __shfl_xor(v, o);
    return v;
}

struct EpiF32 {
    static constexpr bool PERM = false, AFTER_DRAIN = false;
    float* C; int ldc; const float* bias;
    __device__ __forceinline__ void operator()(const f32x4 (&acc)[2][2][4][2], const Unit& u, int wr, int wc, int fr, int fq) const {
        const int row0 = u.pm * 256 + wr * 64 + fr, col0 = u.pn * 256 + wc * 32 + 4 * fq;
        f32x4 bv[2][2];
#pragma unroll
        for (int bj = 0; bj < 2; ++bj)
#pragma unroll
            for (int n = 0; n < 2; ++n) bv[bj][n] = bias ? *(const f32x4*)(bias + col0 + bj * 128 + n * 16) : (f32x4){0.f, 0.f, 0.f, 0.f};
#pragma unroll
        for (int ai = 0; ai < 2; ++ai)
#pragma unroll
            for (int m = 0; m < 4; ++m) { float* rowp = C + (size_t)(row0 + ai * 128 + m * 16) * ldc + col0;
#pragma unroll
                for (int bj = 0; bj < 2; ++bj)
#pragma unroll
                    for (int n = 0; n < 2; ++n) *(f32x4*)(rowp + bj * 128 + n * 16) = acc[ai][bj][m][n] + bv[bj][n]; }
    }
};
struct EpiSwiglu {
    static constexpr bool PERM = false, AFTER_DRAIN = false;
    bf16_t* O;
    __device__ __forceinline__ void operator()(const f32x4 (&acc)[2][2][4][2], const Unit& u, int wr, int wc, int fr, int fq) const {
        const int row0 = u.pm * 256 + wr * 64 + fr, col0 = u.pn * 128 + wc * 16 + 4 * fq;
#pragma unroll
        for (int ai = 0; ai < 2; ++ai)
#pragma unroll
            for (int m = 0; m < 4; ++m) { bf16_t* rowp = O + (size_t)(row0 + ai * 128 + m * 16) * 2816 + col0;
#pragma unroll
                for (int bj = 0; bj < 2; ++bj) { const f32x4 g = acc[ai][bj][m][0], v = acc[ai][bj][m][1];
                    u32x2 w; w.x = cvt_pk_bf16(siluf_(g[0]) * v[0], siluf_(g[1]) * v[1]); w.y = cvt_pk_bf16(siluf_(g[2]) * v[2], siluf_(g[3]) * v[3]);
                    *(u32x2*)(rowp + bj * 64) = w; } }
    }
};
struct EpiBf16 {
    static constexpr bool PERM = false, AFTER_DRAIN = false;
    bf16_t* O; int ldc;
    __device__ __forceinline__ void operator()(const f32x4 (&acc)[2][2][4][2], const Unit& u, int wr, int wc, int fr, int fq) const {
        const int row0 = u.pm * 256 + wr * 64 + fr, col0 = u.pn * 256 + wc * 32 + 4 * fq;
#pragma unroll
        for (int ai = 0; ai < 2; ++ai)
#pragma unroll
            for (int m = 0; m < 4; ++m) { bf16_t* rowp = O + (size_t)(row0 + ai * 128 + m * 16) * ldc + col0;
#pragma unroll
                for (int bj = 0; bj < 2; ++bj)
#pragma unroll
                    for (int n = 0; n < 2; ++n) { const f32x4 v = acc[ai][bj][m][n]; u32x2 w; w.x = cvt_pk_bf16(v[0], v[1]); w.y = cvt_pk_bf16(v[2], v[3]);
                        *(u32x2*)(rowp + bj * 128 + n * 16) = w; } }
    }
};
struct EpiEvenIn {
    static constexpr bool PERM = false, AFTER_DRAIN = false;
    bf16_t* QKV; float* XGR;
    __device__ __forceinline__ void operator()(const f32x4 (&acc)[2][2][4][2], const Unit& u, int wr, int wc, int fr, int fq) const {
        if (u.pn < 3) { EpiBf16 e{QKV, 768}; e(acc, u, wr, wc, fr, fq); }
        else { Unit u2 = u; u2.pn = u.pn - 3; EpiF32 e{XGR, 1024, nullptr}; e(acc, u2, wr, wc, fr, fq); }
    }
};


struct EpiAny {
    static constexpr bool PERM = false, AFTER_DRAIN = false;
    int mode; void* o1; void* o2; int ldc; const float* bias;
    __device__ __forceinline__ void operator()(const f32x4 (&acc)[2][2][4][2], const Unit& u, int wr, int wc, int fr, int fq) const {
        if (mode == 0) { EpiF32 e{(float*)o1, ldc, bias}; e(acc, u, wr, wc, fr, fq); }
        else if (mode == 1) { EpiSwiglu e{(bf16_t*)o1}; e(acc, u, wr, wc, fr, fq); }
        else if (mode == 2) { EpiBf16 e{(bf16_t*)o1, ldc}; e(acc, u, wr, wc, fr, fq); }
        else { EpiEvenIn e{(bf16_t*)o1, (float*)o2}; e(acc, u, wr, wc, fr, fq); }
    }
};

__device__ void phase_convert(KP p, unsigned char* lds) {
    float* tile = (float*)lds;
    const int tid = tidx();
    constexpr int NJ = 18;
    int total = 0;
    const int tj[4] = {16 * 88, 44 * 16, 0, 0};
    (void)tj;
    total = 4 * 1408 + 4 * 704 + 448 + 256 + 1024 + 256 + 6 * 768;
    for (int g = blockIdx.x; g < total; g += gridDim.x) {
        int r = g, job = 0;
        const float* src; bf16_t* dst; int K, N, perm = 0;
        if (r < 4 * 1408) { job = r / 1408; r -= job * 1408; const int l = job >> 1, second = job & 1;
            src = p->in[second ? I_F2IN : I_F1IN] + (size_t)l * 1024 * 5632; dst = (bf16_t*)(p->ws + WS_FIN + (size_t)job * SZ_FIN); K = 1024; N = 5632; perm = 1; }
        else if ((r -= 4 * 1408) < 4 * 704) { job = r / 704; r -= job * 704; const int l = job >> 1, second = job & 1;
            src = p->in[second ? I_F2OUT : I_F1OUT] + (size_t)l * 2816 * 1024; dst = (bf16_t*)(p->ws + WS_FOUT + (size_t)job * SZ_FOUT); K = 2816; N = 1024; }
        else if ((r -= 4 * 704) < 448) { src = p->in[I_EIN]; dst = (bf16_t*)(p->ws + WS_EIN); K = 1024; N = 1792; }
        else if ((r -= 448) < 256) { src = p->in[I_EOUT]; dst = (bf16_t*)(p->ws + WS_EOUT); K = 1024; N = 1024; }
        else if ((r -= 256) < 1024) { src = p->in[I_OIN]; dst = (bf16_t*)(p->ws + WS_OIN); K = 1024; N = 4096; }
        else if ((r -= 1024) < 256) { src = p->in[I_OOUT]; dst = (bf16_t*)(p->ws + WS_OOUT); K = 1024; N = 1024; }
        else { r -= 256; job = r / 768; r -= job * 768; src = p->in[I_ADAW] + (size_t)job * 1024 * 3072; dst = (bf16_t*)(p->ws + WS_ADA + (size_t)job * 3072 * 1024 * 2); K = 1024; N = 3072; }
        const int ntn = N / 64, kt = r / ntn, nt = r - kt * ntn, k0 = kt * 64, n0 = nt * 64;
        __syncthreads();
#pragma unroll
        for (int i = 0; i < 2; ++i) { const int idx = tid + i * 512, rr = idx >> 4, c4 = (idx & 15) * 4;
            const float4 v = *(const float4*)(src + (size_t)(k0 + rr) * N + n0 + c4);
            float* t = tile + rr * 65 + c4; t[0] = v.x; t[1] = v.y; t[2] = v.z; t[3] = v.w; }
        __syncthreads();
        { const int n = tid >> 3, ks = (tid & 7) * 8; const float* t = tile + ks * 65 + n;
            u32x4 w; w.x = cvt_pk_bf16(t[0], t[65]); w.y = cvt_pk_bf16(t[130], t[195]); w.z = cvt_pk_bf16(t[260], t[325]); w.w = cvt_pk_bf16(t[390], t[455]);
            int c = n0 + n, drow = c;
            if (perm) { const int half = c >= 2816, cc = half ? c - 2816 : c; drow = (cc >> 4) * 32 + half * 16 + (cc & 15); }
            *(u32x4*)(dst + (size_t)drow * K + k0 + ks) = w; }
    }
    (void)NJ;
    bf16_t* aada = (bf16_t*)(p->ws + WS_AADA);
    for (int i = blockIdx.x * 512 + tid; i < 256 * 1024; i += gridDim.x * 512) { const int b = i >> 10, k = i & 1023;
        float v = 0.f; if (b < 8) v = siluf_(p->in[I_CP][b * 1024 + k]); else if (b < 136) v = siluf_(p->in[I_CS][(b - 8) * 1024 + k]);
        aada[i] = f2bf(v); }
    float* rope = (float*)(p->ws + WS_ROPE);
    for (int i = blockIdx.x * 512 + tid; i < 2052 * 8; i += gridDim.x * 512) { const int pi = i >> 3, f = i & 7;
        const float pos = (float)(pi < 2048 ? pi : 16384 + (pi - 2048));
        const float inv = powf(500000.0f, -(float)(2 * f) / 16.0f);
        const float ang = pos * inv; float s, c; sincosf(ang, &s, &c);
        rope[pi * 16 + f] = c; rope[pi * 16 + 8 + f] = s; }
}

__device__ void phase_rowop(KP p, int idx) {
    const int lane = tidx() & 63, wave = tidx() >> 6;
    float* X = p->out; const float* Y = (const float*)(p->ws + WS_Y); const float* MOD = (const float*)(p->ws + WS_MOD); bf16_t* H = (bf16_t*)(p->ws + WS_H);
    const int prev = idx - 1; const float rw = (prev % 3 == 1) ? 1.0f : 0.5f;
    for (int row = blockIdx.x * 8 + wave; row < TT; row += gridDim.x * 8) {
        const int b = row < TP ? (row >> 11) : 8 + ((row - TP) >> 2);
        float4 x[4];
        if (idx == 0) { const float* src = row < TP ? p->in[I_XP] + (size_t)row * 1024 : p->in[I_XS] + (size_t)(row - TP) * 1024;
#pragma unroll
            for (int i = 0; i < 4; ++i) x[i] = *(const float4*)(src + i * 256 + lane * 4); }
        else {
            float4 y[4]; float ss = 0.f;
#pragma unroll
            for (int i = 0; i < 4; ++i) { y[i] = *(const float4*)(Y + (size_t)row * 1024 + i * 256 + lane * 4); x[i] = *(const float4*)(X + (size_t)row * 1024 + i * 256 + lane * 4);
                ss += y[i].x * y[i].x + y[i].y * y[i].y + y[i].z * y[i].z + y[i].w * y[i].w; }
            ss = wave_sum(ss); const float inv = rsqrtf(ss * (1.0f / 1024.0f) + 1e-6f);
            const float* gate = MOD + (size_t)b * NMOD + prev * 3072 + 2048; const float* gp = p->in[I_NPOST] + prev * 1024;
#pragma unroll
            for (int i = 0; i < 4; ++i) { const float4 g = *(const float4*)(gate + i * 256 + lane * 4), q = *(const float4*)(gp + i * 256 + lane * 4);
                x[i].x += rw * (1.f + g.x) * (y[i].x * inv) * q.x; x[i].y += rw * (1.f + g.y) * (y[i].y * inv) * q.y;
                x[i].z += rw * (1.f + g.z) * (y[i].z * inv) * q.z; x[i].w += rw * (1.f + g.w) * (y[i].w * inv) * q.w; }
        }
#pragma unroll
        for (int i = 0; i < 4; ++i) *(float4*)(X + (size_t)row * 1024 + i * 256 + lane * 4) = x[i];
        if (idx < 6) {
            float ss = 0.f;
#pragma unroll
            for (int i = 0; i < 4; ++i) ss += x[i].x * x[i].x + x[i].y * x[i].y + x[i].z * x[i].z + x[i].w * x[i].w;
            ss = wave_sum(ss); const float inv = rsqrtf(ss * (1.0f / 1024.0f) + 1e-6f);
            const float* sh = MOD + (size_t)b * NMOD + idx * 3072; const float* gq = p->in[I_NPRE] + idx * 1024;
#pragma unroll
            for (int i = 0; i < 4; ++i) { const float4 s = *(const float4*)(sh + i * 256 + lane * 4), sc = *(const float4*)(sh + 1024 + i * 256 + lane * 4), q = *(const float4*)(gq + i * 256 + lane * 4);
                u32x2 w; w.x = cvt_pk_bf16((x[i].x * inv) * q.x * (1.f + sc.x) + s.x, (x[i].y * inv) * q.y * (1.f + sc.y) + s.y);
                w.y = cvt_pk_bf16((x[i].z * inv) * q.z * (1.f + sc.z) + s.z, (x[i].w * inv) * q.w * (1.f + sc.w) + s.w);
                *(u32x2*)(H + (size_t)row * 1024 + i * 256 + lane * 4) = w; }
        }
    }
}

__device__ __forceinline__ void rope16(u32x4& a, u32x4& b, const float* rt) {
    float x1[8], x2[8];
    x1[0] = bf_lo(a.x); x1[1] = bf_hi(a.x); x1[2] = bf_lo(a.y); x1[3] = bf_hi(a.y); x1[4] = bf_lo(a.z); x1[5] = bf_hi(a.z); x1[6] = bf_lo(a.w); x1[7] = bf_hi(a.w);
    x2[0] = bf_lo(b.x); x2[1] = bf_hi(b.x); x2[2] = bf_lo(b.y); x2[3] = bf_hi(b.y); x2[4] = bf_lo(b.z); x2[5] = bf_hi(b.z); x2[6] = bf_lo(b.w); x2[7] = bf_hi(b.w);
    float o1[8], o2[8];
#pragma unroll
    for (int i = 0; i < 8; ++i) { const float c = rt[i], s = rt[8 + i]; o1[i] = x1[i] * c - x2[i] * s; o2[i] = x2[i] * c + x1[i] * s; }
    a.x = cvt_pk_bf16(o1[0], o1[1]); a.y = cvt_pk_bf16(o1[2], o1[3]); a.z = cvt_pk_bf16(o1[4], o1[5]); a.w = cvt_pk_bf16(o1[6], o1[7]);
    b.x = cvt_pk_bf16(o2[0], o2[1]); b.y = cvt_pk_bf16(o2[2], o2[3]); b.z = cvt_pk_bf16(o2[4], o2[5]); b.w = cvt_pk_bf16(o2[6], o2[7]);
}
__device__ __forceinline__ void st_f32x8(float* dst, const u32x4 v) {
    *(float4*)dst = make_float4(bf_lo(v.x), bf_hi(v.x), bf_lo(v.y), bf_hi(v.y)); *(float4*)(dst + 4) = make_float4(bf_lo(v.z), bf_hi(v.z), bf_lo(v.w), bf_hi(v.w));
}

__device__ void attn_prompt_item(KP p, unsigned char* lds, int item) {
    const int b = item >> 5, n = (item >> 1) & 15, kvh = item & 1;
    bf16_t* Ks = (bf16_t*)lds;
    bf16_t* Vt = Ks + 256 * 72;
    bf16_t* Qs = Vt + 64 * 264;
    const bf16_t* QKV = (const bf16_t*)(p->ws + WS_QKV); const float* rope = (const float*)(p->ws + WS_ROPE);
    bf16_t* Z = (bf16_t*)(p->ws + WS_Z);
    const int tid = tidx();
    __syncthreads();
    {
        const int key = tid >> 1, dh = tid & 1, pos = n * 128 - 128 + key;
        u32x4 kk[4], vv[4];
        if (pos >= 0) { const bf16_t* src = QKV + (size_t)(b * 2048 + pos) * 768 + 512 + kvh * 64 + dh * 32;
#pragma unroll
            for (int i = 0; i < 4; ++i) { kk[i] = *(const u32x4*)(src + i * 8); vv[i] = *(const u32x4*)(src + 128 + i * 8); }
            if (dh == 0) rope16(kk[0], kk[1], rope + pos * 16);
        } else {
#pragma unroll
            for (int i = 0; i < 4; ++i) { kk[i] = (u32x4){0u, 0u, 0u, 0u}; vv[i] = kk[i]; } }
#pragma unroll
        for (int i = 0; i < 4; ++i) *(u32x4*)(Ks + key * 72 + dh * 32 + i * 8) = kk[i];
#pragma unroll
        for (int i = 0; i < 4; ++i) { const unsigned w[4] = {vv[i].x, vv[i].y, vv[i].z, vv[i].w};
#pragma unroll
            for (int j = 0; j < 4; ++j) { Vt[(dh * 32 + i * 8 + j * 2) * 264 + key] = (bf16_t)(w[j] & 0xffffu); Vt[(dh * 32 + i * 8 + j * 2 + 1) * 264 + key] = (bf16_t)(w[j] >> 16); } }
        if (n == 15 && key >= 128) { float* ko = p->out + O_KWP + ((size_t)(b * 128 + key - 128) * 2 + kvh) * 64 + dh * 32; float* vo = p->out + O_VWP + ((size_t)(b * 128 + key - 128) * 2 + kvh) * 64 + dh * 32;
#pragma unroll
            for (int i = 0; i < 4; ++i) { st_f32x8(ko + i * 8, kk[i]); st_f32x8(vo + i * 8, vv[i]); } }
    }
    {
        const int row = tid, g = row >> 7, qi = row & 127, pos = n * 128 + qi;
        const bf16_t* src = QKV + (size_t)(b * 2048 + pos) * 768 + (kvh * 4 + g) * 64;
        u32x4 q[8];
#pragma unroll
        for (int i = 0; i < 8; ++i) q[i] = *(const u32x4*)(src + i * 8);
        rope16(q[0], q[1], rope + pos * 16);
#pragma unroll
        for (int i = 0; i < 8; ++i) *(u32x4*)(Qs + row * 72 + i * 8) = q[i];
    }
    __syncthreads();
    const int w = tid >> 6, l = tid & 63, fr = l & 15, fq = l >> 4;
    const int head = kvh * 4 + (w >> 1);
    const float sink = p->in[I_SINK][head];
#pragma unroll 1
    for (int sb = 0; sb < 2; ++sb) {
        const int q0 = (w & 1) * 64 + sb * 32, kb = q0;
        const bf16_t* Qw = Qs + ((w >> 1) * 128 + q0) * 72;
        bf16x8 qf[2][2];
#pragma unroll
        for (int nt = 0; nt < 2; ++nt)
#pragma unroll
            for (int ks = 0; ks < 2; ++ks) qf[nt][ks] = *(const bf16x8*)(Qw + (nt * 16 + fr) * 72 + ks * 32 + fq * 8);
        f32x4 s[10][2];
#pragma unroll
        for (int mt = 0; mt < 10; ++mt) {
            bf16x8 kf[2];
#pragma unroll
            for (int ks = 0; ks < 2; ++ks) kf[ks] = *(const bf16x8*)(Ks + (kb + mt * 16 + fr) * 72 + ks * 32 + fq * 8);
#pragma unroll
            for (int nt = 0; nt < 2; ++nt) { f32x4 a = {0.f, 0.f, 0.f, 0.f};
                a = __builtin_amdgcn_mfma_f32_16x16x32_bf16(kf[0], qf[nt][0], a, 0, 0, 0);
                a = __builtin_amdgcn_mfma_f32_16x16x32_bf16(kf[1], qf[nt][1], a, 0, 0, 0); s[mt][nt] = a; }
        }
        bf16x8 pf[5][2];
#pragma unroll
        for (int nt = 0; nt < 2; ++nt) {
            const int qi = q0 + nt * 16 + fr;
            float m = sink;
#pragma unroll
            for (int mt = 0; mt < 10; ++mt)
#pragma unroll
                for (int r = 0; r < 4; ++r) { const int j = kb + mt * 16 + fq * 4 + r; const bool ok = (j > qi) && (j <= qi + 128) && (n > 0 || j >= 128);
                    const float v = ok ? s[mt][nt][r] * 0.125f : -INFINITY; s[mt][nt][r] = v; m = fmaxf(m, v); }
            m = fmaxf(m, __shfl_xor(m, 16)); m = fmaxf(m, __shfl_xor(m, 32));
            float sum = 0.f;
#pragma unroll
            for (int mt = 0; mt < 10; ++mt)
#pragma unroll
                for (int r = 0; r < 4; ++r) { const float e = __expf(s[mt][nt][r] - m); s[mt][nt][r] = e; sum += e; }
            sum += __shfl_xor(sum, 16); sum += __shfl_xor(sum, 32);
            const float rinv = 1.f / (sum + __expf(sink - m));
#pragma unroll
            for (int kp = 0; kp < 5; ++kp) { const f32x4 a = s[2 * kp][nt] * rinv, c = s[2 * kp + 1][nt] * rinv;
                u32x4 t; t.x = cvt_pk_bf16(a[0], a[1]); t.y = cvt_pk_bf16(a[2], a[3]); t.z = cvt_pk_bf16(c[0], c[1]); t.w = cvt_pk_bf16(c[2], c[3]);
                pf[kp][nt] = __builtin_bit_cast(bf16x8, t); }
        }
        f32x4 o[4][2];
#pragma unroll
        for (int dt = 0; dt < 4; ++dt) {
#pragma unroll
            for (int nt = 0; nt < 2; ++nt) o[dt][nt] = (f32x4){0.f, 0.f, 0.f, 0.f};
#pragma unroll
            for (int kp = 0; kp < 5; ++kp) { const bf16_t* vp = Vt + (dt * 16 + fr) * 264 + kb + kp * 32 + fq * 4;
                u32x4 t; const u32x2 lo = *(const u32x2*)vp, hi = *(const u32x2*)(vp + 16); t.x = lo.x; t.y = lo.y; t.z = hi.x; t.w = hi.y;
                const bf16x8 vf = __builtin_bit_cast(bf16x8, t);
#pragma unroll
                for (int nt = 0; nt < 2; ++nt) o[dt][nt] = __builtin_amdgcn_mfma_f32_16x16x32_bf16(vf, pf[kp][nt], o[dt][nt], 0, 0, 0); }
        }
#pragma unroll
        for (int nt = 0; nt < 2; ++nt) { const int tok = b * 2048 + n * 128 + q0 + nt * 16 + fr;
#pragma unroll
            for (int dt = 0; dt < 4; ++dt) { u32x2 wv; wv.x = cvt_pk_bf16(o[dt][nt][0], o[dt][nt][1]); wv.y = cvt_pk_bf16(o[dt][nt][2], o[dt][nt][3]);
                *(u32x2*)(Z + (size_t)tok * 1024 + head * 64 + dt * 16 + fq * 4) = wv; } }
    }
}

__device__ void attn_sample_item(KP p, unsigned char* lds, int item) {
    const int bs = item >> 1, kvh = item & 1;
    float* Kf = (float*)lds;
    float* Vf = Kf + 132 * 65;
    float* Qf = Vf + 132 * 64;
    float* Sc = Qf + 16 * 64;
    const bf16_t* QKV = (const bf16_t*)(p->ws + WS_QKV); const float* rope = (const float*)(p->ws + WS_ROPE);
    bf16_t* Z = (bf16_t*)(p->ws + WS_Z);
    const int tid = tidx();
    __syncthreads();
    for (int i = tid; i < 128 * 16; i += 512) { const int key = i >> 4, d4 = (i & 15) * 4; const size_t off = ((size_t)(bs * 128 + key) * 2 + kvh) * 64 + d4;
        const float4 k = *(const float4*)(p->in[I_CK] + off), v = *(const float4*)(p->in[I_CV] + off);
        float* kd = Kf + key * 65 + d4; kd[0] = k.x; kd[1] = k.y; kd[2] = k.z; kd[3] = k.w; *(float4*)(Vf + key * 64 + d4) = v;
        if (key >= 4) { const size_t oo = ((size_t)(bs * 128 + key - 4) * 2 + kvh) * 64 + d4; *(float4*)(p->out + O_KWS + oo) = k; *(float4*)(p->out + O_VWS + oo) = v; } }
    if (tid < 256) { const int t = tid >> 6, d = tid & 63; const int tok = TP + bs * 4 + t; const bf16_t* src = QKV + (size_t)tok * 768;
        float kx = bf1(src[512 + kvh * 64 + d]); const float vx = bf1(src[640 + kvh * 64 + d]);
        if (d < 16) { const float* rt = rope + (2048 + t) * 16; const float other = bf1(src[512 + kvh * 64 + (d ^ 8)]); const int f = d & 7;
            kx = d < 8 ? kx * rt[f] - other * rt[8 + f] : kx * rt[f] + other * rt[8 + f]; }
        Kf[(128 + t) * 65 + d] = kx; Vf[(128 + t) * 64 + d] = vx;
        const size_t oo = ((size_t)(bs * 128 + 124 + t) * 2 + kvh) * 64 + d; p->out[O_KWS + oo] = kx; p->out[O_VWS + oo] = vx; }
    for (int i = tid; i < 1024; i += 512) { const int row = i >> 6, d = i & 63, g = row >> 2, t = row & 3; const int tok = TP + bs * 4 + t;
        const bf16_t* src = QKV + (size_t)tok * 768 + (kvh * 4 + g) * 64;
        float qx = bf1(src[d]);
        if (d < 16) { const float* rt = rope + (2048 + t) * 16; const float other = bf1(src[d ^ 8]); const int f = d & 7;
            qx = d < 8 ? qx * rt[f] - other * rt[8 + f] : qx * rt[f] + other * rt[8 + f]; }
        Qf[row * 64 + d] = qx; }
    __syncthreads();
    for (int i = tid; i < 16 * 132; i += 512) { const int row = i / 132, key = i - row * 132, t = row & 3;
        const bool ok = key < 128 ? (key > t) : (key - 128 <= t);
        float a = 0.f;
#pragma unroll 8
        for (int d = 0; d < 64; ++d) a += Qf[row * 64 + d] * Kf[key * 65 + d];
        Sc[row * 136 + key] = ok ? a * 0.125f : -INFINITY; }
    __syncthreads();
    { const int w = tid >> 6, l = tid & 63;
#pragma unroll
        for (int rr = 0; rr < 2; ++rr) { const int row = w * 2 + rr; const float sink = p->in[I_SINK][kvh * 4 + (row >> 2)];
            float v0 = Sc[row * 136 + l], v1 = Sc[row * 136 + 64 + l], v2 = (l < 4) ? Sc[row * 136 + 128 + l] : -INFINITY;
            float m = fmaxf(fmaxf(v0, v1), fmaxf(v2, sink));
#pragma unroll
            for (int o = 32; o > 0; o >>= 1) m = fmaxf(m, __shfl_xor(m, o));
            v0 = __expf(v0 - m); v1 = __expf(v1 - m); v2 = __expf(v2 - m);
            const float sum = wave_sum(v0 + v1 + v2) + __expf(sink - m); const float rinv = 1.f / sum;
            Sc[row * 136 + l] = v0 * rinv; Sc[row * 136 + 64 + l] = v1 * rinv; if (l < 4) Sc[row * 136 + 128 + l] = v2 * rinv; } }
    __syncthreads();
    { const int row = tid >> 5, d = (tid & 31) * 2, g = row >> 2, t = row & 3; float a0 = 0.f, a1 = 0.f;
        for (int key = 0; key < 132; ++key) { const float pr = Sc[row * 136 + key]; a0 += pr * Vf[key * 64 + d]; a1 += pr * Vf[key * 64 + d + 1]; }
        const int tok = TP + bs * 4 + t;
        *(unsigned*)(Z + (size_t)tok * 1024 + (kvh * 4 + g) * 64 + d) = cvt_pk_bf16(a0, a1); }
}

__device__ void gates_item(KP p, unsigned char* lds, int tile) {
    float* xcs = (float*)lds;
    const int c = tidx(), t0 = tile * 32;
    const float* XR = (const float*)(p->ws + WS_XGR) + 512;
    float* LA = (float*)(p->ws + WS_LA); float* LB = (float*)(p->ws + WS_LB);
    const float cw0 = p->in[I_CONVW][c], cw1 = p->in[I_CONVW][512 + c], cw2 = p->in[I_CONVW][1024 + c], cw3 = p->in[I_CONVW][1536 + c], cb = p->in[I_CONVB][c];
    __syncthreads();
    if (t0 < TP) {
        const int b = t0 >> 11, tau0 = t0 & 2047;
        float xm3 = 0.f, xm2 = 0.f, xm1 = 0.f;
        if (tau0 > 0) { xm3 = XR[(size_t)(t0 - 3) * 1024 + c]; xm2 = XR[(size_t)(t0 - 2) * 1024 + c]; xm1 = XR[(size_t)(t0 - 1) * 1024 + c]; }
#pragma unroll 8
        for (int i = 0; i < 32; ++i) { const float x = XR[(size_t)(t0 + i) * 1024 + c];
            xcs[i * 512 + c] = cb + cw0 * xm3 + cw1 * xm2 + cw2 * xm1 + cw3 * x; xm3 = xm2; xm2 = xm1; xm1 = x; }
        if (tau0 + 32 == 2048) { float* co = p->out + O_CONVP + (size_t)b * 3 * 512 + c; co[0] = xm3; co[512] = xm2; co[1024] = xm1; }
    } else {
#pragma unroll 1
        for (int s = 0; s < 8; ++s) { const int bs = ((t0 - TP) >> 2) + s; const float* cs = p->in[I_SCONV] + (size_t)bs * 3 * 512 + c;
            float xm3 = cs[0], xm2 = cs[512], xm1 = cs[1024];
#pragma unroll
            for (int i = 0; i < 4; ++i) { const float x = XR[(size_t)(t0 + s * 4 + i) * 1024 + c];
                xcs[(s * 4 + i) * 512 + c] = cb + cw0 * xm3 + cw1 * xm2 + cw2 * xm1 + cw3 * x; xm3 = xm2; xm2 = xm1; xm1 = x; }
            float* co = p->out + O_CONVS + (size_t)bs * 3 * 512 + c; co[0] = xm3; co[512] = xm2; co[1024] = xm1; }
    }
    __syncthreads();
    const int k = c >> 6, e = c & 63;
    float* rs = xcs + 32 * 512;
    const float lam = p->in[I_LAM][c]; const float sp = log1pf(__expf(-lam));
#pragma unroll 1
    for (int gsel = 0; gsel < 2; ++gsel) {
        const float* W = p->in[gsel ? I_WX : I_WA] + (size_t)(k * 64) * 64 + e;
        float wr_[64];
#pragma unroll
        for (int d = 0; d < 64; ++d) wr_[d] = W[d * 64];
        const float bias = p->in[gsel ? I_BX : I_BA][c];
#pragma unroll 1
        for (int t = 0; t < 32; ++t) {
            float a0 = bias, a1 = 0.f; const float* xr = xcs + t * 512 + k * 64;
#pragma unroll
            for (int d4 = 0; d4 < 16; d4 += 2) { const float4 x = *(const float4*)(xr + d4 * 4), y = *(const float4*)(xr + d4 * 4 + 4);
                a0 += x.x * wr_[d4 * 4] + x.y * wr_[d4 * 4 + 1] + x.z * wr_[d4 * 4 + 2] + x.w * wr_[d4 * 4 + 3];
                a1 += y.x * wr_[d4 * 4 + 4] + y.y * wr_[d4 * 4 + 5] + y.z * wr_[d4 * 4 + 6] + y.w * wr_[d4 * 4 + 7]; }
            const float sg = sigmoidf_(a0 + a1);
            if (gsel == 0) rs[t * 512 + c] = sg;
            else { const float r = rs[t * 512 + c];
                const float log_a = -8.0f * r * sp; const float a = __expf(log_a);
                const float mult = sqrtf(fmaxf(1.0f - __expf(2.0f * log_a), 0.0f));
                const float xc = xcs[t * 512 + c];
                LA[(size_t)(t0 + t) * 512 + c] = a; LB[(size_t)(t0 + t) * 512 + c] = mult * (sg * xc); }
        }
    }
}

__device__ void phase_mix_a(KP p, unsigned char* lds) {
#ifndef NO_AP
    for (int it = blockIdx.x; it < 256; it += gridDim.x) attn_prompt_item(p, lds, it);
#endif
#ifndef NO_AS
    for (int it = blockIdx.x; it < 256; it += gridDim.x) attn_sample_item(p, lds, it);
#endif
#ifndef NO_GT
    for (int it = blockIdx.x; it < 528; it += gridDim.x) gates_item(p, lds, it);
#endif
}

__device__ __forceinline__ float gelu_tanh(float x) { const float u = 0.7978845608028654f * (x + 0.044715f * x * x * x); return 0.5f * x * (1.f + tanhf(u)); }
__device__ void phase_mix_b(KP p, unsigned char* lds) {
    const float* LA = (const float*)(p->ws + WS_LA); const float* LB = (const float*)(p->ws + WS_LB);
    const float* XG = (const float*)(p->ws + WS_XGR); bf16_t* Z = (bf16_t*)(p->ws + WS_Z);
    float* sA = (float*)lds; float* sB = sA + 512;
    const int tid = tidx();
    for (int it = blockIdx.x; it < 256; it += gridDim.x) {
        if (it < 128) {
            const int b = it >> 4, c = (it & 15) * 32 + (tid & 31), ch = tid >> 5;
            const size_t base = (size_t)(b * 2048 + ch * 128);
            float A = 1.f, B = 0.f;
#pragma unroll 8
            for (int i = 0; i < 128; ++i) { const float a = LA[(base + i) * 512 + c], bb = LB[(base + i) * 512 + c]; B = a * B + bb; A *= a; }
            __syncthreads();
            sA[tid] = A; sB[tid] = B;
            __syncthreads();
            float h = 0.f;
            for (int j = 0; j < ch; ++j) h = sA[j * 32 + (tid & 31)] * h + sB[j * 32 + (tid & 31)];
#pragma unroll 8
            for (int i = 0; i < 128; ++i) { const float a = LA[(base + i) * 512 + c], bb = LB[(base + i) * 512 + c]; h = a * h + bb;
                const float g = gelu_tanh(XG[(base + i) * 1024 + c]); Z[(base + i) * 1024 + 512 + c] = f2bf(g * h); }
            if (ch == 15) p->out[O_HP + b * 512 + c] = h;
        } else {
            const int bs = it - 128, c = tid; float h = p->in[I_SH][bs * 512 + c];
#pragma unroll
            for (int i = 0; i < 4; ++i) { const size_t tok = TP + bs * 4 + i; h = LA[tok * 512 + c] * h + LB[tok * 512 + c];
                const float g = gelu_tanh(XG[tok * 1024 + c]); Z[tok * 1024 + 512 + c] = f2bf(g * h); }
            p->out[O_HS + bs * 512 + c] = h;
        }
    }
}

__device__ void hgrn_item(KP p, unsigned char* lds, int tok0, int ntok, const float* s0, float* sout, int h, int vs) {
    float* qs = (float*)lds;
    float* fs = qs + 32 * 128;
    float* vsm = fs + 32 * 128;
    float* op = vsm + 32 * 32;
    const bf16_t* QF = (const bf16_t*)(p->ws + WS_QFVG); bf16_t* Z = (bf16_t*)(p->ws + WS_Z);
    const int tid = tidx(), v = tid & 31, kg = tid >> 5;
    float S[8];
#pragma unroll
    for (int i = 0; i < 8; ++i) S[i] = s0 ? s0[(size_t)(kg * 8 + i) * 128 + vs * 32 + v] : 0.f;
    const int ks = tid & 127; const float l0 = p->in[I_LB][h * 128 + ks], l1 = p->in[I_LB][1024 + h * 128 + ks];
    const float lb = 1.f / (1.f + __expf(l0 - l1));
    for (int t0 = 0; t0 < ntok; t0 += 32) {
        const int nb = (ntok - t0) < 32 ? (ntok - t0) : 32;
        __syncthreads();
        for (int i = tid; i < nb * 128; i += 512) { const int t = i >> 7; const bf16_t* src = QF + (size_t)(tok0 + t0 + t) * 4096 + h * 128 + ks;
            qs[t * 128 + ks] = bf1(src[0]); fs[t * 128 + ks] = lb + (1.f - lb) * sigmoidf_(bf1(src[1024])); }
        for (int i = tid; i < nb * 32; i += 512) { const int t = i >> 5, vv = i & 31; vsm[t * 32 + vv] = bf1(QF[(size_t)(tok0 + t0 + t) * 4096 + 2048 + h * 128 + vs * 32 + vv]); }
        __syncthreads();
        for (int t = 0; t < nb; ++t) {
            const float4 f0 = *(const float4*)(fs + t * 128 + kg * 8), f1 = *(const float4*)(fs + t * 128 + kg * 8 + 4);
            const float4 q0 = *(const float4*)(qs + t * 128 + kg * 8), q1 = *(const float4*)(qs + t * 128 + kg * 8 + 4);
            const float vv = vsm[t * 32 + v];
            const float f[8] = {f0.x, f0.y, f0.z, f0.w, f1.x, f1.y, f1.z, f1.w}, q[8] = {q0.x, q0.y, q0.z, q0.w, q1.x, q1.y, q1.z, q1.w};
            float o = 0.f;
#pragma unroll
            for (int i = 0; i < 8; ++i) { S[i] = f[i] * S[i] + (1.f - f[i]) * vv; o += q[i] * S[i]; }
            op[(kg * 32 + t) * 32 + v] = o;
        }
        __syncthreads();
        for (int i = tid; i < nb * 32; i += 512) { const int t = i >> 5, vv = i & 31; float o = 0.f;
#pragma unroll
            for (int g = 0; g < 16; ++g) o += op[(g * 32 + t) * 32 + vv];
            Z[(size_t)(tok0 + t0 + t) * 1024 + h * 128 + vs * 32 + vv] = f2bf(o); }
    }
#pragma unroll
    for (int i = 0; i < 8; ++i) sout[(size_t)(kg * 8 + i) * 128 + vs * 32 + v] = S[i];
}
__device__ void phase_hgrn(KP p, unsigned char* lds) {
    for (int it = blockIdx.x; it < 256; it += gridDim.x) { const int b = it >> 5, h = (it >> 2) & 7, vs = it & 3;
        hgrn_item(p, lds, b * 2048, 2048, nullptr, p->out + O_SP + (size_t)(b * 8 + h) * 16384, h, vs); }
    for (int it = blockIdx.x; it < 4096; it += gridDim.x) { const int bs = it >> 5, h = (it >> 2) & 7, vs = it & 3;
        hgrn_item(p, lds, TP + bs * 4, 4, p->in[I_SS] + (size_t)(bs * 8 + h) * 16384, p->out + O_SS + (size_t)(bs * 8 + h) * 16384, h, vs); }
}
__device__ void phase_znorm(KP p) {
    const int lane = tidx() & 63, wave = tidx() >> 6;
    bf16_t* Z = (bf16_t*)(p->ws + WS_Z); const bf16_t* QF = (const bf16_t*)(p->ws + WS_QFVG);
    float gn[16];
#pragma unroll
    for (int i = 0; i < 16; ++i) gn[i] = p->in[I_GN][(lane & 7) * 16 + i];
    for (int row = blockIdx.x * 8 + wave; row < TT; row += gridDim.x * 8) {
        bf16_t* zp = Z + (size_t)row * 1024 + lane * 16; const bf16_t* gp = QF + (size_t)row * 4096 + 3072 + lane * 16;
        const u32x4 a = *(const u32x4*)zp, b2 = *(const u32x4*)(zp + 8), ga = *(const u32x4*)gp, gb = *(const u32x4*)(gp + 8);
        const unsigned ow[8] = {a.x, a.y, a.z, a.w, b2.x, b2.y, b2.z, b2.w}, gw[8] = {ga.x, ga.y, ga.z, ga.w, gb.x, gb.y, gb.z, gb.w};
        float o[16], g[16]; float ss = 0.f;
#pragma unroll
        for (int i = 0; i < 8; ++i) { o[2 * i] = bf_lo(ow[i]); o[2 * i + 1] = bf_hi(ow[i]); g[2 * i] = bf_lo(gw[i]); g[2 * i + 1] = bf_hi(gw[i]); ss += o[2 * i] * o[2 * i] + o[2 * i + 1] * o[2 * i + 1]; }
        ss += __shfl_xor(ss, 1); ss += __shfl_xor(ss, 2); ss += __shfl_xor(ss, 4);
        const float inv = rsqrtf(ss * (1.0f / 128.0f) + 1e-6f);
        unsigned w[8];
#pragma unroll
        for (int i = 0; i < 8; ++i) w[i] = cvt_pk_bf16((o[2 * i] * inv) * gn[2 * i] * siluf_(g[2 * i]), (o[2 * i + 1] * inv) * gn[2 * i + 1] * siluf_(g[2 * i + 1]));
        *(u32x4*)zp = (u32x4){w[0], w[1], w[2], w[3]}; *(u32x4*)(zp + 8) = (u32x4){w[4], w[5], w[6], w[7]};
    }
}

template <class Epi> __device__ __forceinline__ void run_gemm(unsigned char* lds, const bf16_t* A, const bf16_t* Bt, int M, int N, int K, const Epi& E) {
    pg8::Gemm g; g.A = A; g.Bt = Bt; g.M = M; g.N = N; g.K = K;
    pg8::StaticOrder S; S.init(M, N, (int)gridDim.x, (int)blockIdx.x);
    pg8::gemm_phase<Epi, pg8::StaticOrder, false>((PG8_LAS unsigned char*)lds, g, S, E, nullptr);
}
constexpr int N_PHASES = 25;
#ifndef PH_MASK
#define PH_MASK 0xffffffffu
#endif
#define PHX(k, call) do { if constexpr ((PH_MASK >> (k)) & 1u) { call; } } while (0)
__global__ __launch_bounds__(512, 2) void hybrid_fwd(Params p_arg) {
    extern __shared__ __attribute__((aligned(16))) unsigned char shm[];
    cg::grid_group grid = cg::this_grid();
    const int ph_lo = p_arg.ph_lo, ph_hi = p_arg.ph_hi;
    for (int ph = ph_lo; ph < ph_hi; ++ph) {
        KP p = (KP)__builtin_amdgcn_kernarg_segment_ptr(); asm volatile("" : "+s"(p));
        unsigned char* ws = p->ws;
        int kind, arg = 0;
        switch (ph) {
            case 0: kind = 0; break;            case 1: kind = 1; break;
            case 2: kind = 2; arg = 0; break;   case 3: kind = 3; arg = 0; break;   case 4: kind = 4; arg = 0; break;
            case 5: kind = 2; arg = 1; break;   case 6: kind = 5; break;            case 7: kind = 6; break;   case 8: kind = 7; break;   case 9: kind = 8; break;
            case 10: kind = 2; arg = 2; break;  case 11: kind = 3; arg = 1; break;  case 12: kind = 4; arg = 1; break;
            case 13: kind = 2; arg = 3; break;  case 14: kind = 3; arg = 2; break;  case 15: kind = 4; arg = 2; break;
            case 16: kind = 2; arg = 4; break;  case 17: kind = 9; break;           case 18: kind = 10; break;  case 19: kind = 11; break;  case 20: kind = 12; break;
            case 21: kind = 2; arg = 5; break;  case 22: kind = 3; arg = 3; break;  case 23: kind = 4; arg = 3; break;
            default: kind = 2; arg = 6; break;
        }
        const bf16_t* gA = nullptr; const bf16_t* gB = nullptr; int gM = TT, gN = 1024, gK = 1024; EpiAny ge{0, nullptr, nullptr, 1024, nullptr};
        if (kind == 1) { gA = (const bf16_t*)(ws + WS_AADA); gB = (const bf16_t*)(ws + WS_ADA); gM = 256; gN = NMOD; ge = EpiAny{0, ws + WS_MOD, nullptr, NMOD, p->in[I_ADAB]}; }
        else if (kind == 3) { gA = (const bf16_t*)(ws + WS_H); gB = (const bf16_t*)(ws + WS_FIN + (size_t)arg * SZ_FIN); gN = 5632; ge = EpiAny{1, ws + WS_A2, nullptr, 2816, nullptr}; }
        else if (kind == 4) { gA = (const bf16_t*)(ws + WS_A2); gB = (const bf16_t*)(ws + WS_FOUT + (size_t)arg * SZ_FOUT); gK = 2816; ge = EpiAny{0, ws + WS_Y, nullptr, 1024, nullptr}; }
        else if (kind == 8) { gA = (const bf16_t*)(ws + WS_Z); gB = (const bf16_t*)(ws + WS_EOUT); ge = EpiAny{0, ws + WS_Y, nullptr, 1024, nullptr}; }
        else if (kind == 12) { gA = (const bf16_t*)(ws + WS_Z); gB = (const bf16_t*)(ws + WS_OOUT); ge = EpiAny{0, ws + WS_Y, nullptr, 1024, nullptr}; }
        else if (kind == 5) { gA = (const bf16_t*)(ws + WS_H); gB = (const bf16_t*)(ws + WS_EIN); gN = 1792; ge = EpiAny{3, ws + WS_QKV, ws + WS_XGR, 768, nullptr}; }
        else if (kind == 9) { gA = (const bf16_t*)(ws + WS_H); gB = (const bf16_t*)(ws + WS_OIN); gN = 4096; ge = EpiAny{2, ws + WS_QFVG, nullptr, 4096, nullptr}; }
        if (gA) { PHX(1, run_gemm(shm, gA, gB, gM, gN, gK, ge)); }
        else if (kind == 0) { PHX(0, phase_convert(p, shm)); }
        else if (kind == 2) { PHX(2, phase_rowop(p, arg)); }
        else if (kind == 6) { PHX(6, phase_mix_a(p, shm)); }
        else if (kind == 7) { PHX(7, phase_mix_b(p, shm)); }
        else if (kind == 10) { PHX(10, phase_hgrn(p, shm)); }
        else if (kind == 11) { PHX(11, phase_znorm(p)); }
        if (ph + 1 < ph_hi) grid.sync();
    }
}

extern "C" void kernel_launch(void* const* d_in, const int* in_sizes, int n_in, void* d_out, int out_size, void* d_ws, size_t ws_size, hipStream_t stream) {
    static int grid = 0;
    if (grid == 0) {
        if (n_in != N_INPUTS || out_size != 39862272 || ws_size < WS_END) { fprintf(stderr, "kernel_launch: unexpected shapes: n_in %d out %d ws %zu (need %zu)\n", n_in, out_size, ws_size, (size_t)WS_END); grid = -1; return; }
        int dev = 0, cus = 0, per_cu = 0;
        hipGetDevice(&dev); hipDeviceGetAttribute(&cus, hipDeviceAttributeMultiprocessorCount, dev);
        if (hipFuncSetAttribute((const void*)hybrid_fwd, hipFuncAttributeMaxDynamicSharedMemorySize, LDS_BYTES) != hipSuccess) { fprintf(stderr, "kernel_launch: hipFuncSetAttribute failed\n"); grid = -1; return; }
        hipOccupancyMaxActiveBlocksPerMultiprocessor(&per_cu, (const void*)hybrid_fwd, 512, LDS_BYTES);
        (void)hipGetLastError();
        if (per_cu < 1) per_cu = 1;
        grid = cus;
        fprintf(stderr, "kernel_launch: cus %d per_cu %d grid %d ws %zu\n", cus, per_cu, grid, ws_size);
    }
    if (grid < 0) return;
    Params p{};
    for (int i = 0; i < N_INPUTS; ++i) p.in[i] = (const float*)d_in[i];
    p.out = (float*)d_out; p.ws = (unsigned char*)d_ws; p.ph_lo = 0; p.ph_hi = N_PHASES;
    void* args[] = {&p};
    hipError_t e = hipLaunchCooperativeKernel((const void*)hybrid_fwd, dim3(grid), dim3(512), args, LDS_BYTES, stream);
    if (e != hipSuccess) fprintf(stderr, "cooperative launch failed: %s (grid %d)\n", hipGetErrorString(e), grid);
}
```

```cpp
#include <hip/hip_runtime.h>
#include <hip/hip_cooperative_groups.h>
#include <cstdio>
namespace cg = cooperative_groups;
__device__ __forceinline__ int tidx() { int t = threadIdx.x; asm volatile("" : "+v"(t)); return t; }
namespace pg8 {
#define PG8_LAS __attribute__((address_space(3)))
typedef unsigned short bf16_t;
typedef short bf16x8 __attribute__((ext_vector_type(8)));
typedef float f32x4 __attribute__((ext_vector_type(4)));
typedef unsigned u32x4 __attribute__((ext_vector_type(4)));
constexpr int BM = 256, BK = 64, HALF = 128, HTB = HALF * BK * 2  , STAGE_BYTES = 8 * HTB, NXCD = 8, WGM = 8;

__host__ __device__ __forceinline__ int lds_byte(int r, int c) { const int st = (r >> 4) * 2 + (c >> 5), rr = r & 15, cc = c & 31, ob = rr * 64 + cc * 2; return st * 1024 + (ob ^ (((ob >> 9) & 1) << 5)); }
__host__ __device__ __forceinline__ void stage_rc(int b, int& R, int& C) { const int st = b / 1024, sb = b % 1024, swz = sb ^ (((sb >> 9) & 1) << 5); R = (st >> 1) * 16 + swz / 64; C = (st & 1) * 32 + (swz % 64) / 2; }
__host__ __device__ __forceinline__ int perm32(int rho) { const int n = rho >> 4, i = rho & 15; return 8 * (i >> 2) + 4 * n + (i & 3); }

struct Unit { int pm, pn, k0, nt, slab; };
struct Gemm { const bf16_t* A; const bf16_t* Bt; int M, N, K; };

struct StaticOrder {
    int nM, nN, nwg, G, c, ntk, split;
    __host__ __device__ void init(int M, int N, int G_, int c_, int K_ = 1024, int split_ = 0) { nM = M / BM; nN = N / BM; nwg = nM * nN; G = G_; c = c_; ntk = K_ / BK; split = split_; }
    __host__ __device__ bool next(int i, Unit& u) const {
        const long L = (long)i * G + c;
        u.k0 = 0; u.nt = ntk; u.slab = -1;
        if (split > 0) {
            if (L < 256) { const int x = (int)L & 7, j = (int)L >> 3; u.pm = 8 * x + (j & 7); u.pn = j >> 3; return true; }
            const int s = (int)L - 256; if (s >= 8 * split) return false;
            const int tile = s / split, sl = s - tile * split; u.pm = 64 + (tile >> 2); u.pn = tile & 3; u.nt = ntk / split; u.k0 = sl * u.nt * BK; u.slab = sl; return true;
        }
        if (L >= nwg) return false;
        int wgid = (int)L; { const int q = nwg / NXCD, r = nwg % NXCD, xcd = wgid % NXCD, off = wgid / NXCD; wgid = (xcd < r ? xcd * (q + 1) : r * (q + 1) + (xcd - r) * q) + off; }
        const int nig = WGM * nN, gid = wgid / nig, fm = gid * WGM, gsz = (nM - fm) < WGM ? (nM - fm) : WGM;
        u.pm = fm + ((wgid % nig) % gsz); u.pn = (wgid % nig) / gsz; return true;
    }
    __device__ __forceinline__ void a_ready(const Unit&) const {}
    __device__ __forceinline__ void done(const Unit&) const {}
};
typedef __bf16 hwbf16x2 __attribute__((ext_vector_type(2))); typedef float hwf32x2 __attribute__((ext_vector_type(2)));
__device__ __forceinline__ unsigned cvt_pk_bf16(float lo, float hi) { const hwf32x2 v = {lo, hi}; const hwbf16x2 r = __builtin_convertvector(v, hwbf16x2); return __builtin_bit_cast(unsigned, r); }
template <class Epi, class Sched, bool STAMP = false>
__device__ __forceinline__ void gemm_phase(PG8_LAS unsigned char* lds, const Gemm g, const Sched& S, const Epi& E, unsigned long long* stamps) {
    const int tid = tidx(), wid = __builtin_amdgcn_readfirstlane(tid >> 6), lane = tid & 63, wr = wid >> 2, wc = wid & 3, fr = lane & 15, fq = lane >> 4;
    const int K = g.K;
    int ts_lo = 0, ts_hi = 0, nts = 0; const unsigned long long rt_entry = STAMP ? (unsigned long long)wall_clock64() : 0ull;
#define PG8_STAMP() do { if (STAMP && wid == 0 && nts < 64) { const unsigned long long _c = (unsigned long long)clock64(); \
        ts_lo = (lane == nts) ? (int)(unsigned)_c : ts_lo; ts_hi = (lane == nts) ? (int)(unsigned)(_c >> 32) : ts_hi; ++nts; } } while (0)
    PG8_STAMP();
    unsigned voffA[2], voffB[2];
#pragma unroll
    for (int i = 0; i < 2; ++i) { int R, C; stage_rc(tid * 16 + i * 8192, R, C); const int Rb = Epi::PERM ? ((R & ~31) + perm32(R & 31)) : R;
        voffA[i] = (unsigned)(R * K + C) * 2u; voffB[i] = (unsigned)(Rb * K + C) * 2u; }
    const size_t kstep = (size_t)(BK * 2);
    const size_t hstep = (size_t)HALF * K * 2;
    const size_t tstep = 2 * hstep;
    const unsigned ldsw = (unsigned)wid * 1024u;
    const int aoff = lds_byte(wr * 64 + fr, fq * 8), boff = lds_byte(wc * 32 + fr, fq * 8);
#define PG8_SA(b, h) (((b) * 2 + (h)) * HTB)
#define PG8_SB(b, h) ((4 + (b) * 2 + (h)) * HTB)
#define PG8_STAGE(bufoff, gbase, voff) do { _Pragma("unroll") for (int _i = 0; _i < 2; ++_i) \
        __builtin_amdgcn_global_load_lds((const unsigned*)((const char*)(gbase) + (voff)[_i]), (PG8_LAS unsigned*)(lds + (bufoff) + ldsw + _i * 8192), 16, 0, 0); } while (0)
#define PG8_LDA(dst, b, h) do { _Pragma("unroll") for (int m = 0; m < 4; ++m) _Pragma("unroll") for (int k = 0; k < 2; ++k) dst[m][k] = *(const PG8_LAS bf16x8*)(lds + PG8_SA(b, h) + aoff + m * 2048 + k * 1024); } while (0)
#define PG8_LDB(dst, b, h) do { _Pragma("unroll") for (int n = 0; n < 2; ++n) _Pragma("unroll") for (int k = 0; k < 2; ++k) dst[n][k] = *(const PG8_LAS bf16x8*)(lds + PG8_SB(b, h) + boff + n * 2048 + k * 1024); } while (0)
#define PG8_MMA(ai, bj, At, Bt) do { __builtin_amdgcn_s_setprio(1); _Pragma("unroll") for (int m = 0; m < 4; ++m) _Pragma("unroll") for (int n = 0; n < 2; ++n) _Pragma("unroll") for (int k = 0; k < 2; ++k) \
        acc[ai][bj][m][n] = __builtin_amdgcn_mfma_f32_16x16x32_bf16(Bt[n][k], At[m][k], acc[ai][bj][m][n], 0, 0, 0); __builtin_amdgcn_s_setprio(0); } while (0)
#define PG8_WAIT_V(n) asm volatile("s_waitcnt vmcnt(" #n ")" ::: "memory")
#define PG8_WAIT_L(n) asm volatile("s_waitcnt lgkmcnt(" #n ")" ::: "memory")
#define PG8_BAR __builtin_amdgcn_s_barrier()
#define PG8_SCHED __builtin_amdgcn_sched_barrier(0)
    Unit cur, nxt; int ui = 0;
    if (!S.next(0, cur)) return;
    f32x4 acc[2][2][4][2];
#pragma unroll
    for (int a = 0; a < 2; ++a)
#pragma unroll
        for (int b = 0; b < 2; ++b)
#pragma unroll
            for (int m = 0; m < 4; ++m)
#pragma unroll
                for (int n = 0; n < 2; ++n) acc[a][b][m][n] = (f32x4){0.f, 0.f, 0.f, 0.f};
    bf16x8 At[4][2], B0[2][2], B1[2][2];
    const char* cA = (const char*)g.A + (size_t)cur.pm * tstep + (size_t)cur.k0 * 2; const char* cB = (const char*)g.Bt + (size_t)cur.pn * tstep + (size_t)cur.k0 * 2;
    S.a_ready(cur);
    PG8_STAGE(PG8_SB(0, 0), cB, voffB); PG8_STAGE(PG8_SA(0, 0), cA, voffA); PG8_STAGE(PG8_SB(0, 1), cB + hstep, voffB); PG8_STAGE(PG8_SA(0, 1), cA + hstep, voffA);
    if (wr == 1) PG8_BAR;
    PG8_WAIT_V(4); PG8_BAR;
    PG8_STAGE(PG8_SB(1, 0), cB + kstep, voffB); PG8_STAGE(PG8_SA(1, 0), cA + kstep, voffA); PG8_STAGE(PG8_SB(1, 1), cB + hstep + kstep, voffB);
    PG8_WAIT_V(6); PG8_BAR;
    PG8_STAMP();
    for (;;) {
        const bool has_next = S.next(ui + 1, nxt);
        const char* nA = has_next ? (const char*)g.A + (size_t)nxt.pm * tstep + (size_t)nxt.k0 * 2 : cA; const char* nB = has_next ? (const char*)g.Bt + (size_t)nxt.pn * tstep + (size_t)nxt.k0 * 2 : cB;
        const int nt = cur.nt;
        for (int t = 0; t < nt; t += 2) {
            const bool last = (t == nt - 2);
            const char* a1 = cA + (size_t)(t + 1) * kstep;
            const char* a2 = last ? nA : cA + (size_t)(t + 2) * kstep; const char* b2 = last ? nB : cB + (size_t)(t + 2) * kstep;
            const char* a3 = a2 + kstep; const char* b3 = b2 + kstep;
            if (last && has_next) S.a_ready(nxt);
            PG8_LDB(B0, 0, 0); PG8_SCHED; PG8_LDA(At, 0, 0); PG8_STAGE(PG8_SA(1, 1), a1 + hstep, voffA);
            PG8_WAIT_L(8); PG8_BAR; PG8_WAIT_L(0); PG8_MMA(0, 0, At, B0); PG8_BAR; PG8_SCHED;
            PG8_LDB(B1, 0, 1); PG8_STAGE(PG8_SB(0, 0), b2, voffB);
            PG8_BAR; PG8_WAIT_L(0); PG8_MMA(0, 1, At, B1); PG8_BAR;
            PG8_LDA(At, 0, 1); PG8_STAGE(PG8_SA(0, 0), a2, voffA);
            PG8_BAR; PG8_WAIT_L(0); PG8_MMA(1, 0, At, B0); PG8_BAR; PG8_SCHED;
            PG8_STAGE(PG8_SB(0, 1), b2 + hstep, voffB);
            PG8_WAIT_V(6); PG8_BAR; PG8_MMA(1, 1, At, B1); PG8_BAR;
            PG8_LDB(B0, 1, 0); PG8_SCHED; PG8_LDA(At, 1, 0); PG8_STAGE(PG8_SA(0, 1), a2 + hstep, voffA);
            PG8_WAIT_L(8); PG8_BAR; PG8_WAIT_L(0); PG8_MMA(0, 0, At, B0); PG8_BAR; PG8_SCHED;
            PG8_LDB(B1, 1, 1); PG8_STAGE(PG8_SB(1, 0), b3, voffB);
            PG8_BAR; PG8_WAIT_L(0); PG8_MMA(0, 1, At, B1); PG8_BAR;
            PG8_LDA(At, 1, 1); PG8_STAGE(PG8_SA(1, 0), a3, voffA);
            PG8_BAR; PG8_WAIT_L(0); PG8_MMA(1, 0, At, B0); PG8_BAR; PG8_SCHED;
            PG8_STAGE(PG8_SB(1, 1), b3 + hstep, voffB);
            PG8_WAIT_V(6); PG8_BAR; PG8_MMA(1, 1, At, B1); PG8_BAR;
        }
        PG8_STAMP();
        if constexpr (!Epi::AFTER_DRAIN) { E(acc, cur, wr, wc, fr, fq); S.done(cur); }
        PG8_STAMP();
        if (!has_next) break;
#pragma unroll
        for (int a = 0; a < 2; ++a)
#pragma unroll
            for (int b = 0; b < 2; ++b)
#pragma unroll
                for (int m = 0; m < 4; ++m)
#pragma unroll
                    for (int n = 0; n < 2; ++n) acc[a][b][m][n] = (f32x4){0.f, 0.f, 0.f, 0.f};
        cur = nxt; cA = nA; cB = nB; ++ui;
    }
    PG8_WAIT_V(0);
    if (wr == 0) PG8_BAR;
    PG8_BAR;
    if constexpr (Epi::AFTER_DRAIN) { E.fused(acc, cur, wr, wc, fr, fq, lds, wid, lane); S.done(cur); }
    PG8_STAMP();
    if (STAMP && wid == 0) { stamps[lane] = lane < nts ? (((unsigned long long)(unsigned)ts_hi << 32) | (unsigned)ts_lo) : 0ull;
        if (lane == 62) stamps[62] = rt_entry; if (lane == 63) stamps[63] = (unsigned long long)wall_clock64(); }
#undef PG8_STAMP
#undef PG8_SA
#undef PG8_SB
#undef PG8_STAGE
#undef PG8_LDA
#undef PG8_LDB
#undef PG8_MMA
#undef PG8_WAIT_V
#undef PG8_WAIT_L
#undef PG8_BAR
#undef PG8_SCHED
}
}
#define XB_TMO      128
#define XB_XCNT(j)  (256  + 64 * (j))
#define XB_XSUB(j)  (1280 + 64 * (j))
#define XB_XGEN(j)  (2304 + 64 * (j))
#define XB_TOP      3328
#define XB_TOPGEN   3392
#define XCD_BAR_WORDS 3456
#define XB_SPIN_CAP (1u << 18)
#define LAS __attribute__((address_space(3)))

__device__ __forceinline__ unsigned xb_ld(unsigned* p)              { return __hip_atomic_load(p, __ATOMIC_RELAXED, __HIP_MEMORY_SCOPE_AGENT); }
__device__ __forceinline__ unsigned xb_add(unsigned* p, unsigned v) { return __hip_atomic_fetch_add(p, v, __ATOMIC_RELAXED, __HIP_MEMORY_SCOPE_AGENT); }
__device__ __forceinline__ unsigned xb_xcc_id() { return (unsigned)__builtin_amdgcn_s_getreg((3 << 11) | 20) & 0xFu; }
#define XB_SPIN(cond, bar) do { unsigned _sp = 0; while (cond) { __builtin_amdgcn_s_sleep(1); \
    if ((++_sp & 255u) == 0u) { if (xb_ld(&(bar)[XB_TMO])) break; if (_sp > XB_SPIN_CAP) { atomicAdd(&(bar)[XB_TMO], 1u); break; } } } } while (0)

struct XcdBarrier {
    unsigned* bar; unsigned x;
    volatile LAS unsigned* st;
};

__device__ __forceinline__ XcdBarrier xcd_barrier_post(unsigned* bar, volatile LAS unsigned* st) {
    XcdBarrier b; b.bar = bar; b.x = xb_xcc_id(); b.st = st;
    if (tidx() == 0) (void)xb_add(&bar[XB_XCNT(b.x)], 1u);
    return b;
}
__device__ __forceinline__ void xcd_barrier_complete(unsigned* bar, unsigned x, unsigned& nloc, unsigned& nx) {
    const unsigned G = gridDim.x * gridDim.y * gridDim.z;
    unsigned sum, cnt, mine, sp = 0u;
    for (;;) {
        sum = 0u; cnt = 0u; mine = 0u;
#pragma unroll
        for (unsigned j = 0; j < 16; ++j) { const unsigned c = xb_ld(&bar[XB_XCNT(j)]); sum += c; cnt += (c > 0u) ? 1u : 0u; mine = (j == x) ? c : mine; }
        if (sum == G) break;
        __builtin_amdgcn_s_sleep(1);
        if ((++sp & 255u) == 0u) { if (xb_ld(&bar[XB_TMO])) break; if (sp > XB_SPIN_CAP) { atomicAdd(&bar[XB_TMO], 1u); break; } }
    }
    nloc = mine > 0u ? mine : 1u; nx = cnt > 0u ? cnt : 1u;
}

__device__ __forceinline__ void xcd_barrier(const XcdBarrier& b) {
    asm volatile("s_waitcnt vmcnt(0)" ::: "memory");
    __syncthreads();
    if (tidx() == 0) {
        unsigned* bar = b.bar;
        __builtin_amdgcn_s_waitcnt(0);
        unsigned nloc = b.st[0], nx = b.st[1];
        if (nloc == 0u) { xcd_barrier_complete(bar, b.x, nloc, nx); b.st[0] = nloc; b.st[1] = nx; }
        const unsigned old = xb_add(&bar[XB_XSUB(b.x)], 1u);
        const unsigned gen = old / nloc;
        if (old + 1u == (gen + 1u) * nloc) {
            __builtin_amdgcn_fence(__ATOMIC_RELEASE, "agent");
            asm volatile("s_waitcnt vmcnt(0)" ::: "memory");
            const unsigned og = xb_add(&bar[XB_TOP], 1u);
            const unsigned tg = og / nx;
            if (og + 1u == (tg + 1u) * nx) xb_add(&bar[XB_TOPGEN], 1u);
            else XB_SPIN(xb_ld(&bar[XB_TOPGEN]) == tg, bar);
            __builtin_amdgcn_fence(__ATOMIC_ACQUIRE, "agent");
            xb_add(&bar[XB_XGEN(b.x)], 1u);
            asm volatile("s_waitcnt vmcnt(0)" ::: "memory");
        } else {
            XB_SPIN(xb_ld(&bar[XB_XGEN(b.x)]) == gen, bar);
            __builtin_amdgcn_fence(__ATOMIC_ACQUIRE, "agent");
            asm volatile("s_waitcnt vmcnt(0)" ::: "memory");
        }
    }
    __syncthreads();
}


using pg8::bf16_t; using pg8::bf16x8; using pg8::f32x4; using pg8::u32x4; using pg8::Unit; using pg8::cvt_pk_bf16;
typedef unsigned u32x2 __attribute__((ext_vector_type(2)));

constexpr int TP = 16384, TT = 16896, NMOD = 18432;
enum { I_XP = 0, I_XS, I_CP, I_CS, I_CK, I_CV, I_SCONV, I_SH, I_SS, I_NPRE, I_NPOST, I_ADAW, I_ADAB, I_F1IN, I_F1OUT, I_F2IN, I_F2OUT,
       I_EIN, I_EOUT, I_SINK, I_CONVW, I_CONVB, I_WA, I_BA, I_WX, I_BX, I_LAM, I_OIN, I_OOUT, I_LB, I_GN, N_INPUTS };
constexpr size_t O_KWP = 17301504, O_VWP = O_KWP + 131072, O_CONVP = O_VWP + 131072, O_HP = O_CONVP + 12288, O_SP = O_HP + 4096,
                 O_KWS = O_SP + 1048576, O_VWS = O_KWS + 2097152, O_CONVS = O_VWS + 2097152, O_HS = O_CONVS + 196608, O_SS = O_HS + 65536;
constexpr size_t SZ_FIN = 5632ull * 1024 * 2, SZ_FOUT = 1024ull * 2816 * 2;
constexpr size_t WS_FIN = 0, WS_FOUT = WS_FIN + 4 * SZ_FIN, WS_EIN = WS_FOUT + 4 * SZ_FOUT, WS_EOUT = WS_EIN + 1792ull * 1024 * 2,
                 WS_OIN = WS_EOUT + 1024ull * 1024 * 2, WS_OOUT = WS_OIN + 4096ull * 1024 * 2, WS_ADA = WS_OOUT + 1024ull * 1024 * 2,
                 WS_AADA = WS_ADA + 18432ull * 1024 * 2, WS_MOD = WS_AADA + 256ull * 1024 * 2, WS_ROPE = WS_MOD + 256ull * 18432 * 4,
                 WS_H = WS_ROPE + 2052ull * 16 * 4, WS_A2 = WS_H + 16896ull * 1024 * 2, WS_Y = WS_A2 + 16896ull * 2816 * 2,
                 WS_BAR = WS_Y + 16896ull * 1024 * 4, WS_SLAB = WS_BAR + 16384, WS_END = WS_SLAB + 11ull * 512 * 1024 * 4;
constexpr size_t WS_QKV = WS_A2, WS_XGR = WS_A2 + 16896ull * 768 * 2, WS_LA = WS_Y, WS_LB = WS_Y + 16896ull * 512 * 4, WS_Z = WS_H, WS_QFVG = WS_A2;
constexpr int LDS_BYTES = 147456;

struct Params { const float* in[N_INPUTS]; float* out; unsigned char* ws; int ph_lo, ph_hi; };
typedef const __attribute__((address_space(4))) Params* KP;

__device__ __forceinline__ float bf_lo(unsigned u) { return __uint_as_float(u << 16); }
__device__ __forceinline__ float bf_hi(unsigned u) { return __uint_as_float(u & 0xffff0000u); }
__device__ __forceinline__ float bf1(bf16_t u) { return __uint_as_float(((unsigned)u) << 16); }
__device__ __forceinline__ bf16_t f2bf(float f) { return (bf16_t)(cvt_pk_bf16(f, 0.f) & 0xffffu); }
__device__ __forceinline__ float sigmoidf_(float x) { return 1.f / (1.f + __expf(-x)); }
__device__ __forceinline__ float siluf_(float x) { return x / (1.f + __expf(-x)); }
__device__ __forceinline__ float wave_sum(float v) {
#pragma unroll
    for (int o = 32; o > 0; o >>= 1) v += __shfl_xor(v, o);
    return v;
}

struct EpiF32 {
    static constexpr bool PERM = false, AFTER_DRAIN = false;
    float* C; int ldc; const float* bias;
    __device__ __forceinline__ void operator()(const f32x4 (&acc)[2][2][4][2], const Unit& u, int wr, int wc, int fr, int fq) const {
        const int row0 = u.pm * 256 + wr * 64 + fr, col0 = u.pn * 256 + wc * 32 + 4 * fq;
        f32x4 bv[2][2];
#pragma unroll
        for (int bj = 0; bj < 2; ++bj)
#pragma unroll
            for (int n = 0; n < 2; ++n) bv[bj][n] = bias ? *(const f32x4*)(bias + col0 + bj * 128 + n * 16) : (f32x4){0.f, 0.f, 0.f, 0.f};
#pragma unroll
        for (int ai = 0; ai < 2; ++ai)
#pragma unroll
            for (int m = 0; m < 4; ++m) { float* rowp = C + (size_t)(row0 + ai * 128 + m * 16) * ldc + col0;
#pragma unroll
                for (int bj = 0; bj < 2; ++bj)
#pragma unroll
                    for (int n = 0; n < 2; ++n) *(f32x4*)(rowp + bj * 128 + n * 16) = acc[ai][bj][m][n] + bv[bj][n]; }
    }
};
struct EpiSwiglu {
    static constexpr bool PERM = false, AFTER_DRAIN = false;
    bf16_t* O;
    __device__ __forceinline__ void operator()(const f32x4 (&acc)[2][2][4][2], const Unit& u, int wr, int wc, int fr, int fq) const {
        const int row0 = u.pm * 256 + wr * 64 + fr, col0 = u.pn * 128 + wc * 16 + 4 * fq;
#pragma unroll
        for (int ai = 0; ai < 2; ++ai)
#pragma unroll
            for (int m = 0; m < 4; ++m) { bf16_t* rowp = O + (size_t)(row0 + ai * 128 + m * 16) * 2816 + col0;
#pragma unroll
                for (int bj = 0; bj < 2; ++bj) { const f32x4 g = acc[ai][bj][m][0], v = acc[ai][bj][m][1];
                    u32x2 w; w.x = cvt_pk_bf16(siluf_(g[0]) * v[0], siluf_(g[1]) * v[1]); w.y = cvt_pk_bf16(siluf_(g[2]) * v[2], siluf_(g[3]) * v[3]);
                    *(u32x2*)(rowp + bj * 64) = w; } }
    }
};
struct EpiBf16 {
    static constexpr bool PERM = false, AFTER_DRAIN = false;
    bf16_t* O; int ldc;
    __device__ __forceinline__ void operator()(const f32x4 (&acc)[2][2][4][2], const Unit& u, int wr, int wc, int fr, int fq) const {
        const int row0 = u.pm * 256 + wr * 64 + fr, col0 = u.pn * 256 + wc * 32 + 4 * fq;
#pragma unroll
        for (int ai = 0; ai < 2; ++ai)
#pragma unroll
            for (int m = 0; m < 4; ++m) { bf16_t* rowp = O + (size_t)(row0 + ai * 128 + m * 16) * ldc + col0;
#pragma unroll
                for (int bj = 0; bj < 2; ++bj)
#pragma unroll
                    for (int n = 0; n < 2; ++n) { const f32x4 v = acc[ai][bj][m][n]; u32x2 w; w.x = cvt_pk_bf16(v[0], v[1]); w.y = cvt_pk_bf16(v[2], v[3]);
                        *(u32x2*)(rowp + bj * 128 + n * 16) = w; } }
    }
};
struct EpiEvenIn {
    static constexpr bool PERM = false, AFTER_DRAIN = false;
    bf16_t* QKV; float* XGR;
    __device__ __forceinline__ void operator()(const f32x4 (&acc)[2][2][4][2], const Unit& u, int wr, int wc, int fr, int fq) const {
        if (u.pn < 3) { EpiBf16 e{QKV, 768}; e(acc, u, wr, wc, fr, fq); }
        else { Unit u2 = u; u2.pn = u.pn - 3; EpiF32 e{XGR, 1024, nullptr}; e(acc, u2, wr, wc, fr, fq); }
    }
};


struct EpiAny {
    static constexpr bool PERM = false, AFTER_DRAIN = false;
    int mode; void* o1; void* o2; int ldc; const float* bias;
    __device__ __forceinline__ void operator()(const f32x4 (&acc)[2][2][4][2], const Unit& u, int wr, int wc, int fr, int fq) const {
        if (mode == 0) { float* C = u.slab >= 0 ? (float*)o2 + (size_t)u.slab * 524288 - (size_t)16384 * 1024 : (float*)o1; EpiF32 e{C, ldc, bias}; e(acc, u, wr, wc, fr, fq); }
        else if (mode == 1) { EpiSwiglu e{(bf16_t*)o1}; e(acc, u, wr, wc, fr, fq); }
        else if (mode == 2) { EpiBf16 e{(bf16_t*)o1, ldc}; e(acc, u, wr, wc, fr, fq); }
        else { EpiEvenIn e{(bf16_t*)o1, (float*)o2}; e(acc, u, wr, wc, fr, fq); }
    }
};

__device__ void phase_convert(KP p, unsigned char* lds) {
    float* tile = (float*)lds;
    const int tid = tidx();
    constexpr int NJ = 18;
    int total = 0;
    const int tj[4] = {16 * 88, 44 * 16, 0, 0};
    (void)tj;
    total = 4 * 1408 + 4 * 704 + 448 + 256 + 1024 + 256 + 6 * 768;
    for (int g = blockIdx.x; g < total; g += gridDim.x) {
        int r = g, job = 0;
        const float* src; bf16_t* dst; int K, N, perm = 0;
        if (r < 4 * 1408) { job = r / 1408; r -= job * 1408; const int l = job >> 1, second = job & 1;
            src = p->in[second ? I_F2IN : I_F1IN] + (size_t)l * 1024 * 5632; dst = (bf16_t*)(p->ws + WS_FIN + (size_t)job * SZ_FIN); K = 1024; N = 5632; perm = 1; }
        else if ((r -= 4 * 1408) < 4 * 704) { job = r / 704; r -= job * 704; const int l = job >> 1, second = job & 1;
            src = p->in[second ? I_F2OUT : I_F1OUT] + (size_t)l * 2816 * 1024; dst = (bf16_t*)(p->ws + WS_FOUT + (size_t)job * SZ_FOUT); K = 2816; N = 1024; }
        else if ((r -= 4 * 704) < 448) { src = p->in[I_EIN]; dst = (bf16_t*)(p->ws + WS_EIN); K = 1024; N = 1792; }
        else if ((r -= 448) < 256) { src = p->in[I_EOUT]; dst = (bf16_t*)(p->ws + WS_EOUT); K = 1024; N = 1024; }
        else if ((r -= 256) < 1024) { src = p->in[I_OIN]; dst = (bf16_t*)(p->ws + WS_OIN); K = 1024; N = 4096; }
        else if ((r -= 1024) < 256) { src = p->in[I_OOUT]; dst = (bf16_t*)(p->ws + WS_OOUT); K = 1024; N = 1024; }
        else { r -= 256; job = r / 768; r -= job * 768; src = p->in[I_ADAW] + (size_t)job * 1024 * 3072; dst = (bf16_t*)(p->ws + WS_ADA + (size_t)job * 3072 * 1024 * 2); K = 1024; N = 3072; }
        const int ntn = N / 64, kt = r / ntn, nt = r - kt * ntn, k0 = kt * 64, n0 = nt * 64;
        __syncthreads();
#pragma unroll
        for (int i = 0; i < 2; ++i) { const int idx = tid + i * 512, rr = idx >> 4, c4 = (idx & 15) * 4;
            const float4 v = *(const float4*)(src + (size_t)(k0 + rr) * N + n0 + c4);
            float* t = tile + rr * 65 + c4; t[0] = v.x; t[1] = v.y; t[2] = v.z; t[3] = v.w; }
        __syncthreads();
        { const int n = tid >> 3, ks = (tid & 7) * 8; const float* t = tile + ks * 65 + n;
            u32x4 w; w.x = cvt_pk_bf16(t[0], t[65]); w.y = cvt_pk_bf16(t[130], t[195]); w.z = cvt_pk_bf16(t[260], t[325]); w.w = cvt_pk_bf16(t[390], t[455]);
            int c = n0 + n, drow = c;
            if (perm) { const int half = c >= 2816, cc = half ? c - 2816 : c; drow = (cc >> 4) * 32 + half * 16 + (cc & 15); }
            *(u32x4*)(dst + (size_t)drow * K + k0 + ks) = w; }
    }
    (void)NJ;
    bf16_t* aada = (bf16_t*)(p->ws + WS_AADA);
    for (int i = blockIdx.x * 512 + tid; i < 256 * 1024; i += gridDim.x * 512) { const int b = i >> 10, k = i & 1023;
        float v = 0.f; if (b < 8) v = siluf_(p->in[I_CP][b * 1024 + k]); else if (b < 136) v = siluf_(p->in[I_CS][(b - 8) * 1024 + k]);
        aada[i] = f2bf(v); }
    float* rope = (float*)(p->ws + WS_ROPE);
    for (int i = blockIdx.x * 512 + tid; i < 2052 * 8; i += gridDim.x * 512) { const int pi = i >> 3, f = i & 7;
        const float pos = (float)(pi < 2048 ? pi : 16384 + (pi - 2048));
        const float inv = powf(500000.0f, -(float)(2 * f) / 16.0f);
        const float ang = pos * inv; float s, c; sincosf(ang, &s, &c);
        rope[pi * 16 + f] = c; rope[pi * 16 + 8 + f] = s; }
}

__device__ void phase_rowop(KP p, int idx) {
    const int lane = tidx() & 63, wave = tidx() >> 6;
    float* X = p->out; const float* Y = (const float*)(p->ws + WS_Y); const float* MOD = (const float*)(p->ws + WS_MOD); bf16_t* H = (bf16_t*)(p->ws + WS_H);
    const int prev = idx - 1; const float rw = (prev % 3 == 1) ? 1.0f : 0.5f;
    for (int row = blockIdx.x * 8 + wave; row < TT; row += gridDim.x * 8) {
        const int b = row < TP ? (row >> 11) : 8 + ((row - TP) >> 2);
        float4 x[4];
        if (idx == 0) { const float* src = row < TP ? p->in[I_XP] + (size_t)row * 1024 : p->in[I_XS] + (size_t)(row - TP) * 1024;
#pragma unroll
            for (int i = 0; i < 4; ++i) x[i] = *(const float4*)(src + i * 256 + lane * 4); }
        else {
            float4 y[4]; float ss = 0.f;
            if (row >= TP) {
                const float* SL = (const float*)(p->ws + WS_SLAB) + (size_t)(row - TP) * 1024; const int ns = (prev % 3 == 1) ? 4 : 11;
#pragma unroll
                for (int i = 0; i < 4; ++i) y[i] = make_float4(0.f, 0.f, 0.f, 0.f);
                for (int s2 = 0; s2 < ns; ++s2) {
#pragma unroll
                    for (int i = 0; i < 4; ++i) { const float4 t = *(const float4*)(SL + (size_t)s2 * 524288 + i * 256 + lane * 4); y[i].x += t.x; y[i].y += t.y; y[i].z += t.z; y[i].w += t.w; } }
            }
#pragma unroll
            for (int i = 0; i < 4; ++i) { if (row < TP) y[i] = *(const float4*)(Y + (size_t)row * 1024 + i * 256 + lane * 4); x[i] = *(const float4*)(X + (size_t)row * 1024 + i * 256 + lane * 4);
                ss += y[i].x * y[i].x + y[i].y * y[i].y + y[i].z * y[i].z + y[i].w * y[i].w; }
            ss = wave_sum(ss); const float inv = rsqrtf(ss * (1.0f / 1024.0f) + 1e-6f);
            const float* gate = MOD + (size_t)b * NMOD + prev * 3072 + 2048; const float* gp = p->in[I_NPOST] + prev * 1024;
#pragma unroll
            for (int i = 0; i < 4; ++i) { const float4 g = *(const float4*)(gate + i * 256 + lane * 4), q = *(const float4*)(gp + i * 256 + lane * 4);
                x[i].x += rw * (1.f + g.x) * (y[i].x * inv) * q.x; x[i].y += rw * (1.f + g.y) * (y[i].y * inv) * q.y;
                x[i].z += rw * (1.f + g.z) * (y[i].z * inv) * q.z; x[i].w += rw * (1.f + g.w) * (y[i].w * inv) * q.w; }
        }
#pragma unroll
        for (int i = 0; i < 4; ++i) *(float4*)(X + (size_t)row * 1024 + i * 256 + lane * 4) = x[i];
        if (idx < 6) {
            float ss = 0.f;
#pragma unroll
            for (int i = 0; i < 4; ++i) ss += x[i].x * x[i].x + x[i].y * x[i].y + x[i].z * x[i].z + x[i].w * x[i].w;
            ss = wave_sum(ss); const float inv = rsqrtf(ss * (1.0f / 1024.0f) + 1e-6f);
            const float* sh = MOD + (size_t)b * NMOD + idx * 3072; const float* gq = p->in[I_NPRE] + idx * 1024;
#pragma unroll
            for (int i = 0; i < 4; ++i) { const float4 s = *(const float4*)(sh + i * 256 + lane * 4), sc = *(const float4*)(sh + 1024 + i * 256 + lane * 4), q = *(const float4*)(gq + i * 256 + lane * 4);
                u32x2 w; w.x = cvt_pk_bf16((x[i].x * inv) * q.x * (1.f + sc.x) + s.x, (x[i].y * inv) * q.y * (1.f + sc.y) + s.y);
                w.y = cvt_pk_bf16((x[i].z * inv) * q.z * (1.f + sc.z) + s.z, (x[i].w * inv) * q.w * (1.f + sc.w) + s.w);
                *(u32x2*)(H + (size_t)row * 1024 + i * 256 + lane * 4) = w; }
        }
    }
}

__device__ __forceinline__ void rope16(u32x4& a, u32x4& b, const float* rt) {
    float x1[8], x2[8];
    x1[0] = bf_lo(a.x); x1[1] = bf_hi(a.x); x1[2] = bf_lo(a.y); x1[3] = bf_hi(a.y); x1[4] = bf_lo(a.z); x1[5] = bf_hi(a.z); x1[6] = bf_lo(a.w); x1[7] = bf_hi(a.w);
    x2[0] = bf_lo(b.x); x2[1] = bf_hi(b.x); x2[2] = bf_lo(b.y); x2[3] = bf_hi(b.y); x2[4] = bf_lo(b.z); x2[5] = bf_hi(b.z); x2[6] = bf_lo(b.w); x2[7] = bf_hi(b.w);
    float o1[8], o2[8];
#pragma unroll
    for (int i = 0; i < 8; ++i) { const float c = rt[i], s = rt[8 + i]; o1[i] = x1[i] * c - x2[i] * s; o2[i] = x2[i] * c + x1[i] * s; }
    a.x = cvt_pk_bf16(o1[0], o1[1]); a.y = cvt_pk_bf16(o1[2], o1[3]); a.z = cvt_pk_bf16(o1[4], o1[5]); a.w = cvt_pk_bf16(o1[6], o1[7]);
    b.x = cvt_pk_bf16(o2[0], o2[1]); b.y = cvt_pk_bf16(o2[2], o2[3]); b.z = cvt_pk_bf16(o2[4], o2[5]); b.w = cvt_pk_bf16(o2[6], o2[7]);
}
__device__ __forceinline__ void st_f32x8(float* dst, const u32x4 v) {
    *(float4*)dst = make_float4(bf_lo(v.x), bf_hi(v.x), bf_lo(v.y), bf_hi(v.y)); *(float4*)(dst + 4) = make_float4(bf_lo(v.z), bf_hi(v.z), bf_lo(v.w), bf_hi(v.w));
}

__device__ void attn_prompt_item(KP p, unsigned char* lds, int item) {
    const int b = item >> 5, n = (item >> 1) & 15, kvh = item & 1;
    bf16_t* Ks = (bf16_t*)lds;
    bf16_t* Vt = Ks + 256 * 72;
    bf16_t* Qs = Vt + 64 * 264;
    const bf16_t* QKV = (const bf16_t*)(p->ws + WS_QKV); const float* rope = (const float*)(p->ws + WS_ROPE);
    bf16_t* Z = (bf16_t*)(p->ws + WS_Z);
    const int tid = tidx();
    __syncthreads();
    {
        const int key = tid >> 1, dh = tid & 1, pos = n * 128 - 128 + key;
        u32x4 kk[4], vv[4];
        if (pos >= 0) { const bf16_t* src = QKV + (size_t)(b * 2048 + pos) * 768 + 512 + kvh * 64 + dh * 32;
#pragma unroll
            for (int i = 0; i < 4; ++i) { kk[i] = *(const u32x4*)(src + i * 8); vv[i] = *(const u32x4*)(src + 128 + i * 8); }
            if (dh == 0) rope16(kk[0], kk[1], rope + pos * 16);
        } else {
#pragma unroll
            for (int i = 0; i < 4; ++i) { kk[i] = (u32x4){0u, 0u, 0u, 0u}; vv[i] = kk[i]; } }
#pragma unroll
        for (int i = 0; i < 4; ++i) *(u32x4*)(Ks + key * 72 + dh * 32 + i * 8) = kk[i];
#pragma unroll
        for (int i = 0; i < 4; ++i) { const unsigned w[4] = {vv[i].x, vv[i].y, vv[i].z, vv[i].w};
#pragma unroll
            for (int j = 0; j < 4; ++j) { Vt[(dh * 32 + i * 8 + j * 2) * 264 + key] = (bf16_t)(w[j] & 0xffffu); Vt[(dh * 32 + i * 8 + j * 2 + 1) * 264 + key] = (bf16_t)(w[j] >> 16); } }
        if (n == 15 && key >= 128) { float* ko = p->out + O_KWP + ((size_t)(b * 128 + key - 128) * 2 + kvh) * 64 + dh * 32; float* vo = p->out + O_VWP + ((size_t)(b * 128 + key - 128) * 2 + kvh) * 64 + dh * 32;
#pragma unroll
            for (int i = 0; i < 4; ++i) { st_f32x8(ko + i * 8, kk[i]); st_f32x8(vo + i * 8, vv[i]); } }
    }
    {
        const int row = tid, g = row >> 7, qi = row & 127, pos = n * 128 + qi;
        const bf16_t* src = QKV + (size_t)(b * 2048 + pos) * 768 + (kvh * 4 + g) * 64;
        u32x4 q[8];
#pragma unroll
        for (int i = 0; i < 8; ++i) q[i] = *(const u32x4*)(src + i * 8);
        rope16(q[0], q[1], rope + pos * 16);
#pragma unroll
        for (int i = 0; i < 8; ++i) *(u32x4*)(Qs + row * 72 + i * 8) = q[i];
    }
    __syncthreads();
    const int w = tid >> 6, l = tid & 63, fr = l & 15, fq = l >> 4;
    const int head = kvh * 4 + (w >> 1);
    const float sink = p->in[I_SINK][head];
#pragma unroll 1
    for (int sb = 0; sb < 2; ++sb) {
        const int q0 = (w & 1) * 64 + sb * 32, kb = q0;
        const bf16_t* Qw = Qs + ((w >> 1) * 128 + q0) * 72;
        bf16x8 qf[2][2];
#pragma unroll
        for (int nt = 0; nt < 2; ++nt)
#pragma unroll
            for (int ks = 0; ks < 2; ++ks) qf[nt][ks] = *(const bf16x8*)(Qw + (nt * 16 + fr) * 72 + ks * 32 + fq * 8);
        f32x4 s[10][2];
#pragma unroll
        for (int mt = 0; mt < 10; ++mt) {
            bf16x8 kf[2];
#pragma unroll
            for (int ks = 0; ks < 2; ++ks) kf[ks] = *(const bf16x8*)(Ks + (kb + mt * 16 + fr) * 72 + ks * 32 + fq * 8);
#pragma unroll
            for (int nt = 0; nt < 2; ++nt) { f32x4 a = {0.f, 0.f, 0.f, 0.f};
                a = __builtin_amdgcn_mfma_f32_16x16x32_bf16(kf[0], qf[nt][0], a, 0, 0, 0);
                a = __builtin_amdgcn_mfma_f32_16x16x32_bf16(kf[1], qf[nt][1], a, 0, 0, 0); s[mt][nt] = a; }
        }
        bf16x8 pf[5][2];
#pragma unroll
        for (int nt = 0; nt < 2; ++nt) {
            const int qi = q0 + nt * 16 + fr;
            float m = sink;
#pragma unroll
            for (int mt = 0; mt < 10; ++mt)
#pragma unroll
                for (int r = 0; r < 4; ++r) { const int j = kb + mt * 16 + fq * 4 + r; const bool ok = (j > qi) && (j <= qi + 128) && (n > 0 || j >= 128);
                    const float v = ok ? s[mt][nt][r] * 0.125f : -INFINITY; s[mt][nt][r] = v; m = fmaxf(m, v); }
            m = fmaxf(m, __shfl_xor(m, 16)); m = fmaxf(m, __shfl_xor(m, 32));
            float sum = 0.f;
#pragma unroll
            for (int mt = 0; mt < 10; ++mt)
#pragma unroll
                for (int r = 0; r < 4; ++r) { const float e = __expf(s[mt][nt][r] - m); s[mt][nt][r] = e; sum += e; }
            sum += __shfl_xor(sum, 16); sum += __shfl_xor(sum, 32);
            const float rinv = 1.f / (sum + __expf(sink - m));
#pragma unroll
            for (int kp = 0; kp < 5; ++kp) { const f32x4 a = s[2 * kp][nt] * rinv, c = s[2 * kp + 1][nt] * rinv;
                u32x4 t; t.x = cvt_pk_bf16(a[0], a[1]); t.y = cvt_pk_bf16(a[2], a[3]); t.z = cvt_pk_bf16(c[0], c[1]); t.w = cvt_pk_bf16(c[2], c[3]);
                pf[kp][nt] = __builtin_bit_cast(bf16x8, t); }
        }
        f32x4 o[4][2];
#pragma unroll
        for (int dt = 0; dt < 4; ++dt) {
#pragma unroll
            for (int nt = 0; nt < 2; ++nt) o[dt][nt] = (f32x4){0.f, 0.f, 0.f, 0.f};
#pragma unroll
            for (int kp = 0; kp < 5; ++kp) { const bf16_t* vp = Vt + (dt * 16 + fr) * 264 + kb + kp * 32 + fq * 4;
                u32x4 t; const u32x2 lo = *(const u32x2*)vp, hi = *(const u32x2*)(vp + 16); t.x = lo.x; t.y = lo.y; t.z = hi.x; t.w = hi.y;
                const bf16x8 vf = __builtin_bit_cast(bf16x8, t);
#pragma unroll
                for (int nt = 0; nt < 2; ++nt) o[dt][nt] = __builtin_amdgcn_mfma_f32_16x16x32_bf16(vf, pf[kp][nt], o[dt][nt], 0, 0, 0); }
        }
#pragma unroll
        for (int nt = 0; nt < 2; ++nt) { const int tok = b * 2048 + n * 128 + q0 + nt * 16 + fr;
#pragma unroll
            for (int dt = 0; dt < 4; ++dt) { u32x2 wv; wv.x = cvt_pk_bf16(o[dt][nt][0], o[dt][nt][1]); wv.y = cvt_pk_bf16(o[dt][nt][2], o[dt][nt][3]);
                *(u32x2*)(Z + (size_t)tok * 1024 + head * 64 + dt * 16 + fq * 4) = wv; } }
    }
}

__device__ void attn_sample_item(KP p, unsigned char* lds, int item) {
    const int bs = item >> 1, kvh = item & 1;
    float* Kf = (float*)lds;
    float* Vf = Kf + 132 * 65;
    float* Qf = Vf + 132 * 64;
    float* Sc = Qf + 16 * 64;
    const bf16_t* QKV = (const bf16_t*)(p->ws + WS_QKV); const float* rope = (const float*)(p->ws + WS_ROPE);
    bf16_t* Z = (bf16_t*)(p->ws + WS_Z);
    const int tid = tidx();
    __syncthreads();
    for (int i = tid; i < 128 * 16; i += 512) { const int key = i >> 4, d4 = (i & 15) * 4; const size_t off = ((size_t)(bs * 128 + key) * 2 + kvh) * 64 + d4;
        const float4 k = *(const float4*)(p->in[I_CK] + off), v = *(const float4*)(p->in[I_CV] + off);
        float* kd = Kf + key * 65 + d4; kd[0] = k.x; kd[1] = k.y; kd[2] = k.z; kd[3] = k.w; *(float4*)(Vf + key * 64 + d4) = v;
        if (key >= 4) { const size_t oo = ((size_t)(bs * 128 + key - 4) * 2 + kvh) * 64 + d4; *(float4*)(p->out + O_KWS + oo) = k; *(float4*)(p->out + O_VWS + oo) = v; } }
    if (tid < 256) { const int t = tid >> 6, d = tid & 63; const int tok = TP + bs * 4 + t; const bf16_t* src = QKV + (size_t)tok * 768;
        float kx = bf1(src[512 + kvh * 64 + d]); const float vx = bf1(src[640 + kvh * 64 + d]);
        if (d < 16) { const float* rt = rope + (2048 + t) * 16; const float other = bf1(src[512 + kvh * 64 + (d ^ 8)]); const int f = d & 7;
            kx = d < 8 ? kx * rt[f] - other * rt[8 + f] : kx * rt[f] + other * rt[8 + f]; }
        Kf[(128 + t) * 65 + d] = kx; Vf[(128 + t) * 64 + d] = vx;
        const size_t oo = ((size_t)(bs * 128 + 124 + t) * 2 + kvh) * 64 + d; p->out[O_KWS + oo] = kx; p->out[O_VWS + oo] = vx; }
    for (int i = tid; i < 1024; i += 512) { const int row = i >> 6, d = i & 63, g = row >> 2, t = row & 3; const int tok = TP + bs * 4 + t;
        const bf16_t* src = QKV + (size_t)tok * 768 + (kvh * 4 + g) * 64;
        float qx = bf1(src[d]);
        if (d < 16) { const float* rt = rope + (2048 + t) * 16; const float other = bf1(src[d ^ 8]); const int f = d & 7;
            qx = d < 8 ? qx * rt[f] - other * rt[8 + f] : qx * rt[f] + other * rt[8 + f]; }
        Qf[row * 64 + d] = qx; }
    __syncthreads();
    for (int i = tid; i < 16 * 132; i += 512) { const int row = i / 132, key = i - row * 132, t = row & 3;
        const bool ok = key < 128 ? (key > t) : (key - 128 <= t);
        float a = 0.f;
#pragma unroll 8
        for (int d = 0; d < 64; ++d) a += Qf[row * 64 + d] * Kf[key * 65 + d];
        Sc[row * 136 + key] = ok ? a * 0.125f : -INFINITY; }
    __syncthreads();
    { const int w = tid >> 6, l = tid & 63;
#pragma unroll
        for (int rr = 0; rr < 2; ++rr) { const int row = w * 2 + rr; const float sink = p->in[I_SINK][kvh * 4 + (row >> 2)];
            float v0 = Sc[row * 136 + l], v1 = Sc[row * 136 + 64 + l], v2 = (l < 4) ? Sc[row * 136 + 128 + l] : -INFINITY;
            float m = fmaxf(fmaxf(v0, v1), fmaxf(v2, sink));
#pragma unroll
            for (int o = 32; o > 0; o >>= 1) m = fmaxf(m, __shfl_xor(m, o));
            v0 = __expf(v0 - m); v1 = __expf(v1 - m); v2 = __expf(v2 - m);
            const float sum = wave_sum(v0 + v1 + v2) + __expf(sink - m); const float rinv = 1.f / sum;
            Sc[row * 136 + l] = v0 * rinv; Sc[row * 136 + 64 + l] = v1 * rinv; if (l < 4) Sc[row * 136 + 128 + l] = v2 * rinv; } }
    __syncthreads();
    { const int row = tid >> 5, d = (tid & 31) * 2, g = row >> 2, t = row & 3; float a0 = 0.f, a1 = 0.f;
        for (int key = 0; key < 132; ++key) { const float pr = Sc[row * 136 + key]; a0 += pr * Vf[key * 64 + d]; a1 += pr * Vf[key * 64 + d + 1]; }
        const int tok = TP + bs * 4 + t;
        *(unsigned*)(Z + (size_t)tok * 1024 + (kvh * 4 + g) * 64 + d) = cvt_pk_bf16(a0, a1); }
}

__device__ void gates_item(KP p, unsigned char* lds, int tile) {
    float* xcs = (float*)lds;
    const int c = tidx(), t0 = tile * 32;
    const float* XR = (const float*)(p->ws + WS_XGR) + 512;
    float* LA = (float*)(p->ws + WS_LA); float* LB = (float*)(p->ws + WS_LB);
    const float cw0 = p->in[I_CONVW][c], cw1 = p->in[I_CONVW][512 + c], cw2 = p->in[I_CONVW][1024 + c], cw3 = p->in[I_CONVW][1536 + c], cb = p->in[I_CONVB][c];
    __syncthreads();
    if (t0 < TP) {
        const int b = t0 >> 11, tau0 = t0 & 2047;
        float xm3 = 0.f, xm2 = 0.f, xm1 = 0.f;
        if (tau0 > 0) { xm3 = XR[(size_t)(t0 - 3) * 1024 + c]; xm2 = XR[(size_t)(t0 - 2) * 1024 + c]; xm1 = XR[(size_t)(t0 - 1) * 1024 + c]; }
#pragma unroll 8
        for (int i = 0; i < 32; ++i) { const float x = XR[(size_t)(t0 + i) * 1024 + c];
            xcs[i * 512 + c] = cb + cw0 * xm3 + cw1 * xm2 + cw2 * xm1 + cw3 * x; xm3 = xm2; xm2 = xm1; xm1 = x; }
        if (tau0 + 32 == 2048) { float* co = p->out + O_CONVP + (size_t)b * 3 * 512 + c; co[0] = xm3; co[512] = xm2; co[1024] = xm1; }
    } else {
#pragma unroll 1
        for (int s = 0; s < 8; ++s) { const int bs = ((t0 - TP) >> 2) + s; const float* cs = p->in[I_SCONV] + (size_t)bs * 3 * 512 + c;
            float xm3 = cs[0], xm2 = cs[512], xm1 = cs[1024];
#pragma unroll
            for (int i = 0; i < 4; ++i) { const float x = XR[(size_t)(t0 + s * 4 + i) * 1024 + c];
                xcs[(s * 4 + i) * 512 + c] = cb + cw0 * xm3 + cw1 * xm2 + cw2 * xm1 + cw3 * x; xm3 = xm2; xm2 = xm1; xm1 = x; }
            float* co = p->out + O_CONVS + (size_t)bs * 3 * 512 + c; co[0] = xm3; co[512] = xm2; co[1024] = xm1; }
    }
    __syncthreads();
    const int k = c >> 6, e = c & 63;
    float* rs = xcs + 32 * 512;
    const float lam = p->in[I_LAM][c]; const float sp = log1pf(__expf(-lam));
#pragma unroll 1
    for (int gsel = 0; gsel < 2; ++gsel) {
        const float* W = p->in[gsel ? I_WX : I_WA] + (size_t)(k * 64) * 64 + e;
        float wr_[64];
#pragma unroll
        for (int d = 0; d < 64; ++d) wr_[d] = W[d * 64];
        const float bias = p->in[gsel ? I_BX : I_BA][c];
#pragma unroll 1
        for (int t = 0; t < 32; ++t) {
            float a0 = bias, a1 = 0.f; const float* xr = xcs + t * 512 + k * 64;
#pragma unroll
            for (int d4 = 0; d4 < 16; d4 += 2) { const float4 x = *(const float4*)(xr + d4 * 4), y = *(const float4*)(xr + d4 * 4 + 4);
                a0 += x.x * wr_[d4 * 4] + x.y * wr_[d4 * 4 + 1] + x.z * wr_[d4 * 4 + 2] + x.w * wr_[d4 * 4 + 3];
                a1 += y.x * wr_[d4 * 4 + 4] + y.y * wr_[d4 * 4 + 5] + y.z * wr_[d4 * 4 + 6] + y.w * wr_[d4 * 4 + 7]; }
            const float sg = sigmoidf_(a0 + a1);
            if (gsel == 0) rs[t * 512 + c] = sg;
            else { const float r = rs[t * 512 + c];
                const float log_a = -8.0f * r * sp; const float a = __expf(log_a);
                const float mult = sqrtf(fmaxf(1.0f - __expf(2.0f * log_a), 0.0f));
                const float xc = xcs[t * 512 + c];
                LA[(size_t)(t0 + t) * 512 + c] = a; LB[(size_t)(t0 + t) * 512 + c] = mult * (sg * xc); }
        }
    }
}

__device__ void phase_mix_a(KP p, unsigned char* lds) {
#ifndef NO_AP
    for (int it = blockIdx.x; it < 256; it += gridDim.x) attn_prompt_item(p, lds, it);
#endif
#ifndef NO_AS
    for (int it = blockIdx.x; it < 256; it += gridDim.x) attn_sample_item(p, lds, it);
#endif
#ifndef NO_GT
    for (int it = blockIdx.x; it < 528; it += gridDim.x) gates_item(p, lds, it);
#endif
}

__device__ __forceinline__ float gelu_tanh(float x) { const float u = 0.7978845608028654f * (x + 0.044715f * x * x * x); return 0.5f * x * (1.f + tanhf(u)); }
__device__ void phase_mix_b(KP p, unsigned char* lds) {
    const float* LA = (const float*)(p->ws + WS_LA); const float* LB = (const float*)(p->ws + WS_LB);
    const float* XG = (const float*)(p->ws + WS_XGR); bf16_t* Z = (bf16_t*)(p->ws + WS_Z);
    float* sA = (float*)lds; float* sB = sA + 512;
    const int tid = tidx();
    for (int it = blockIdx.x; it < 256; it += gridDim.x) {
        if (it < 128) {
            const int b = it >> 4, c = (it & 15) * 32 + (tid & 31), ch = tid >> 5;
            const size_t base = (size_t)(b * 2048 + ch * 128);
            float A = 1.f, B = 0.f;
#pragma unroll 8
            for (int i = 0; i < 128; ++i) { const float a = LA[(base + i) * 512 + c], bb = LB[(base + i) * 512 + c]; B = a * B + bb; A *= a; }
            __syncthreads();
            sA[tid] = A; sB[tid] = B;
            __syncthreads();
            float h = 0.f;
            for (int j = 0; j < ch; ++j) h = sA[j * 32 + (tid & 31)] * h + sB[j * 32 + (tid & 31)];
#pragma unroll 8
            for (int i = 0; i < 128; ++i) { const float a = LA[(base + i) * 512 + c], bb = LB[(base + i) * 512 + c]; h = a * h + bb;
                const float g = gelu_tanh(XG[(base + i) * 1024 + c]); Z[(base + i) * 1024 + 512 + c] = f2bf(g * h); }
            if (ch == 15) p->out[O_HP + b * 512 + c] = h;
        } else {
            const int bs = it - 128, c = tid; float h = p->in[I_SH][bs * 512 + c];
#pragma unroll
            for (int i = 0; i < 4; ++i) { const size_t tok = TP + bs * 4 + i; h = LA[tok * 512 + c] * h + LB[tok * 512 + c];
                const float g = gelu_tanh(XG[tok * 1024 + c]); Z[tok * 1024 + 512 + c] = f2bf(g * h); }
            p->out[O_HS + bs * 512 + c] = h;
        }
    }
}

__device__ void hgrn_item(KP p, unsigned char* lds, int tok0, int ntok, const float* s0, float* sout, int h, int vs) {
    float* qs = (float*)lds;
    float* fs = qs + 32 * 128;
    float* vsm = fs + 32 * 128;
    float* op = vsm + 32 * 32;
    const bf16_t* QF = (const bf16_t*)(p->ws + WS_QFVG); bf16_t* Z = (bf16_t*)(p->ws + WS_Z);
    const int tid = tidx(), v = tid & 31, kg = tid >> 5;
    float S[8];
#pragma unroll
    for (int i = 0; i < 8; ++i) S[i] = s0 ? s0[(size_t)(kg * 8 + i) * 128 + vs * 32 + v] : 0.f;
    const int ks = tid & 127; const float l0 = p->in[I_LB][h * 128 + ks], l1 = p->in[I_LB][1024 + h * 128 + ks];
    const float lb = 1.f / (1.f + __expf(l0 - l1));
    for (int t0 = 0; t0 < ntok; t0 += 32) {
        const int nb = (ntok - t0) < 32 ? (ntok - t0) : 32;
        __syncthreads();
        for (int i = tid; i < nb * 128; i += 512) { const int t = i >> 7; const bf16_t* src = QF + (size_t)(tok0 + t0 + t) * 4096 + h * 128 + ks;
            qs[t * 128 + ks] = bf1(src[0]); fs[t * 128 + ks] = lb + (1.f - lb) * sigmoidf_(bf1(src[1024])); }
        for (int i = tid; i < nb * 32; i += 512) { const int t = i >> 5, vv = i & 31; vsm[t * 32 + vv] = bf1(QF[(size_t)(tok0 + t0 + t) * 4096 + 2048 + h * 128 + vs * 32 + vv]); }
        __syncthreads();
        for (int t = 0; t < nb; ++t) {
            const float4 f0 = *(const float4*)(fs + t * 128 + kg * 8), f1 = *(const float4*)(fs + t * 128 + kg * 8 + 4);
            const float4 q0 = *(const float4*)(qs + t * 128 + kg * 8), q1 = *(const float4*)(qs + t * 128 + kg * 8 + 4);
            const float vv = vsm[t * 32 + v];
            const float f[8] = {f0.x, f0.y, f0.z, f0.w, f1.x, f1.y, f1.z, f1.w}, q[8] = {q0.x, q0.y, q0.z, q0.w, q1.x, q1.y, q1.z, q1.w};
            float o = 0.f;
#pragma unroll
            for (int i = 0; i < 8; ++i) { S[i] = f[i] * S[i] + (1.f - f[i]) * vv; o += q[i] * S[i]; }
            op[(kg * 32 + t) * 32 + v] = o;
        }
        __syncthreads();
        for (int i = tid; i < nb * 32; i += 512) { const int t = i >> 5, vv = i & 31; float o = 0.f;
#pragma unroll
            for (int g = 0; g < 16; ++g) o += op[(g * 32 + t) * 32 + vv];
            Z[(size_t)(tok0 + t0 + t) * 1024 + h * 128 + vs * 32 + vv] = f2bf(o); }
    }
#pragma unroll
    for (int i = 0; i < 8; ++i) sout[(size_t)(kg * 8 + i) * 128 + vs * 32 + v] = S[i];
}

__device__ void hgrn_prompt_item(KP p, unsigned char* lds, int b, int h, int vs) {
    const int tid = tidx(), w = tid >> 6, l = tid & 63, fr = l & 15, fq = l >> 4;
    constexpr int QD_B = 32 * 136 * 2, KLT_B = 128 * 40 * 2, VT_B = 32 * 40 * 2, BUF_B = 2 * QD_B + KLT_B + VT_B + 512;
    unsigned char* st_base = lds + 2 * BUF_B;
    const bf16_t* QF = (const bf16_t*)(p->ws + WS_QFVG); bf16_t* Z = (bf16_t*)(p->ws + WS_Z);
    const int tok0 = b * 2048;
    const int k = 16 * w + fr;
    const float l0 = p->in[I_LB][h * 128 + k], l1 = p->in[I_LB][1024 + h * 128 + k];
    const float lb = 1.f / (1.f + __expf(l0 - l1));
    const bf16_t* qsrc = QF + (size_t)(tok0 + 8 * fq) * 4096 + h * 128 + k;
    const int tv = tid >> 4, vp = (tid & 15) * 2;
    const bf16_t* vsrc = QF + (size_t)(tok0 + tv) * 4096 + 2048 + h * 128 + vs * 32 + vp;
    __syncthreads();
    for (int i = tid; i < 32 * 136 / 2; i += 512) ((unsigned*)st_base)[i] = 0u;
    f32x4 S[2] = {(f32x4){0.f, 0.f, 0.f, 0.f}, (f32x4){0.f, 0.f, 0.f, 0.f}};
    unsigned nq[8], nf[8], nv;
#pragma unroll
    for (int i = 0; i < 8; ++i) { nq[i] = qsrc[(size_t)i * 4096]; nf[i] = qsrc[(size_t)i * 4096 + 1024]; }
    nv = *(const unsigned*)vsrc;
#pragma unroll 1
    for (int step = 0; step < 64; ++step) {
        const int pb = step & 1;
        unsigned char* buf = lds + pb * BUF_B;
        bf16_t* Qd = (bf16_t*)buf; bf16_t* Kd = Qd + 32 * 136; bf16_t* KlT = Kd + 32 * 136; bf16_t* VT = KlT + 128 * 40; float* dl = (float*)(VT + 32 * 40);
        unsigned cq[8], cf[8]; const unsigned cv = nv;
#pragma unroll
        for (int i = 0; i < 8; ++i) { cq[i] = nq[i]; cf[i] = nf[i]; }
        if (step + 1 < 64) { const size_t adv = (size_t)(step + 1) * 32 * 4096;
#pragma unroll
            for (int i = 0; i < 8; ++i) { nq[i] = qsrc[adv + (size_t)i * 4096]; nf[i] = qsrc[adv + (size_t)i * 4096 + 1024]; }
            nv = *(const unsigned*)(vsrc + adv); }
        float q[8], kk[8], bb[8]; float run = 0.f;
#pragma unroll
        for (int i = 0; i < 8; ++i) { const float f = lb + (1.f - lb) * sigmoidf_(bf1((bf16_t)cf[i])); kk[i] = 1.f - f; run += __logf(f); bb[i] = run; q[i] = bf1((bf16_t)cq[i]); }
        float off = 0.f;
#pragma unroll
        for (int g = 1; g < 4; ++g) { const float v = __shfl(run, (l - 16 * g) & 63); off += (fq >= g) ? v : 0.f; }
#pragma unroll
        for (int i = 0; i < 8; ++i) bb[i] += off;
        const float bL = __shfl(bb[7], 48 + fr);
        float kl[8];
#pragma unroll
        for (int i = 0; i < 8; ++i) { const int t = 8 * fq + i;
            Qd[t * 136 + k] = f2bf(q[i] * __expf(bb[i])); Kd[t * 136 + k] = f2bf(kk[i] * __expf(-bb[i])); kl[i] = kk[i] * __expf(bL - bb[i]); }
        { u32x4 pk; pk.x = cvt_pk_bf16(kl[0], kl[1]); pk.y = cvt_pk_bf16(kl[2], kl[3]); pk.z = cvt_pk_bf16(kl[4], kl[5]); pk.w = cvt_pk_bf16(kl[6], kl[7]);
            *(u32x4*)(KlT + k * 40 + 8 * fq) = pk; }
        if (fq == 0) dl[k] = __expf(bL);
        VT[vp * 40 + tv] = (bf16_t)(cv & 0xffffu); VT[(vp + 1) * 40 + tv] = (bf16_t)(cv >> 16);
        __syncthreads();
        const bf16_t* STc = (const bf16_t*)(st_base + pb * QD_B); bf16_t* STn = (bf16_t*)(st_base + (pb ^ 1) * QD_B);
        if (w < 4) {
            const int vt = w & 1, tt = w >> 1;
            bf16x8 qf[4];
#pragma unroll
            for (int ks = 0; ks < 4; ++ks) qf[ks] = *(const bf16x8*)(Qd + (16 * tt + fr) * 136 + 32 * ks + 8 * fq);
            f32x4 sc0 = {0.f, 0.f, 0.f, 0.f}, sc1 = {0.f, 0.f, 0.f, 0.f};
#pragma unroll
            for (int ks = 0; ks < 4; ++ks) sc0 = __builtin_amdgcn_mfma_f32_16x16x32_bf16(*(const bf16x8*)(Kd + fr * 136 + 32 * ks + 8 * fq), qf[ks], sc0, 0, 0, 0);
            if (tt == 1) {
#pragma unroll
                for (int ks = 0; ks < 4; ++ks) sc1 = __builtin_amdgcn_mfma_f32_16x16x32_bf16(*(const bf16x8*)(Kd + (16 + fr) * 136 + 32 * ks + 8 * fq), qf[ks], sc1, 0, 0, 0); }
            const int tq = 16 * tt + fr;
#pragma unroll
            for (int r = 0; r < 4; ++r) { if (4 * fq + r > tq) sc0[r] = 0.f; if (16 + 4 * fq + r > tq) sc1[r] = 0.f; }
            u32x4 pt; pt.x = cvt_pk_bf16(sc0[0], sc0[1]); pt.y = cvt_pk_bf16(sc0[2], sc0[3]); pt.z = cvt_pk_bf16(sc1[0], sc1[1]); pt.w = cvt_pk_bf16(sc1[2], sc1[3]);
            const bf16_t* vrow = VT + (16 * vt + fr) * 40;
            u32x4 vv; { const u32x2 lo = *(const u32x2*)(vrow + 4 * fq), hi = *(const u32x2*)(vrow + 16 + 4 * fq); vv.x = lo.x; vv.y = lo.y; vv.z = hi.x; vv.w = hi.y; }
            f32x4 o = {0.f, 0.f, 0.f, 0.f};
            o = __builtin_amdgcn_mfma_f32_16x16x32_bf16(__builtin_bit_cast(bf16x8, vv), __builtin_bit_cast(bf16x8, pt), o, 0, 0, 0);
#pragma unroll
            for (int ks = 0; ks < 4; ++ks) o = __builtin_amdgcn_mfma_f32_16x16x32_bf16(*(const bf16x8*)(STc + (16 * vt + fr) * 136 + 32 * ks + 8 * fq), qf[ks], o, 0, 0, 0);
            u32x2 wv; wv.x = cvt_pk_bf16(o[0], o[1]); wv.y = cvt_pk_bf16(o[2], o[3]);
            *(u32x2*)(Z + (size_t)(tok0 + step * 32 + tq) * 1024 + h * 128 + vs * 32 + 16 * vt + 4 * fq) = wv;
        }
        { const float4 d4 = *(const float4*)(dl + 16 * w + 4 * fq); const bf16x8 klf = *(const bf16x8*)(KlT + (16 * w + fr) * 40 + 8 * fq);
#pragma unroll
            for (int vt = 0; vt < 2; ++vt) { f32x4 a = S[vt]; a[0] *= d4.x; a[1] *= d4.y; a[2] *= d4.z; a[3] *= d4.w;
                a = __builtin_amdgcn_mfma_f32_16x16x32_bf16(klf, *(const bf16x8*)(VT + (16 * vt + fr) * 40 + 8 * fq), a, 0, 0, 0); S[vt] = a;
                u32x2 sv; sv.x = cvt_pk_bf16(a[0], a[1]); sv.y = cvt_pk_bf16(a[2], a[3]);
                *(u32x2*)(STn + (16 * vt + fr) * 136 + 16 * w + 4 * fq) = sv; } }
        __syncthreads();
    }
    float* so = p->out + O_SP + (size_t)(b * 8 + h) * 16384;
#pragma unroll
    for (int vt = 0; vt < 2; ++vt)
#pragma unroll
        for (int r = 0; r < 4; ++r) so[(size_t)(16 * w + 4 * fq + r) * 128 + vs * 32 + 16 * vt + fr] = S[vt][r];
}
__device__ void phase_hgrn(KP p, unsigned char* lds) {
    for (int it = blockIdx.x; it < 256; it += gridDim.x) { const int b = it >> 5, h = (it >> 2) & 7, vs = it & 3;
        hgrn_prompt_item(p, lds, b, h, vs); }
    for (int it = blockIdx.x; it < 4096; it += gridDim.x) { const int bs = it >> 5, h = (it >> 2) & 7, vs = it & 3;
        hgrn_item(p, lds, TP + bs * 4, 4, p->in[I_SS] + (size_t)(bs * 8 + h) * 16384, p->out + O_SS + (size_t)(bs * 8 + h) * 16384, h, vs); }
}
__device__ void phase_znorm(KP p) {
    const int lane = tidx() & 63, wave = tidx() >> 6;
    bf16_t* Z = (bf16_t*)(p->ws + WS_Z); const bf16_t* QF = (const bf16_t*)(p->ws + WS_QFVG);
    float gn[16];
#pragma unroll
    for (int i = 0; i < 16; ++i) gn[i] = p->in[I_GN][(lane & 7) * 16 + i];
    for (int row = blockIdx.x * 8 + wave; row < TT; row += gridDim.x * 8) {
        bf16_t* zp = Z + (size_t)row * 1024 + lane * 16; const bf16_t* gp = QF + (size_t)row * 4096 + 3072 + lane * 16;
        const u32x4 a = *(const u32x4*)zp, b2 = *(const u32x4*)(zp + 8), ga = *(const u32x4*)gp, gb = *(const u32x4*)(gp + 8);
        const unsigned ow[8] = {a.x, a.y, a.z, a.w, b2.x, b2.y, b2.z, b2.w}, gw[8] = {ga.x, ga.y, ga.z, ga.w, gb.x, gb.y, gb.z, gb.w};
        float o[16], g[16]; float ss = 0.f;
#pragma unroll
        for (int i = 0; i < 8; ++i) { o[2 * i] = bf_lo(ow[i]); o[2 * i + 1] = bf_hi(ow[i]); g[2 * i] = bf_lo(gw[i]); g[2 * i + 1] = bf_hi(gw[i]); ss += o[2 * i] * o[2 * i] + o[2 * i + 1] * o[2 * i + 1]; }
        ss += __shfl_xor(ss, 1); ss += __shfl_xor(ss, 2); ss += __shfl_xor(ss, 4);
        const float inv = rsqrtf(ss * (1.0f / 128.0f) + 1e-6f);
        unsigned w[8];
#pragma unroll
        for (int i = 0; i < 8; ++i) w[i] = cvt_pk_bf16((o[2 * i] * inv) * gn[2 * i] * siluf_(g[2 * i]), (o[2 * i + 1] * inv) * gn[2 * i + 1] * siluf_(g[2 * i + 1]));
        *(u32x4*)zp = (u32x4){w[0], w[1], w[2], w[3]}; *(u32x4*)(zp + 8) = (u32x4){w[4], w[5], w[6], w[7]};
    }
}

template <class Epi> __device__ __forceinline__ void run_gemm(unsigned char* lds, const bf16_t* A, const bf16_t* Bt, int M, int N, int K, const Epi& E, int split) {
    pg8::Gemm g; g.A = A; g.Bt = Bt; g.M = M; g.N = N; g.K = K;
    pg8::StaticOrder S; S.init(M, N, (int)gridDim.x, (int)blockIdx.x, K, split);
    pg8::gemm_phase<Epi, pg8::StaticOrder, false>((PG8_LAS unsigned char*)lds, g, S, E, nullptr);
}
constexpr int N_PHASES = 25;
#ifndef PH_MASK
#define PH_MASK 0xffffffffu
#endif
#define PHX(k, call) do { if constexpr ((PH_MASK >> (k)) & 1u) { call; } } while (0)
__global__ __launch_bounds__(512, 2) void hybrid_fwd(Params p_arg) {
    extern __shared__ __attribute__((aligned(16))) unsigned char shm[];
    cg::grid_group grid = cg::this_grid();
    volatile LAS unsigned* xst = (volatile LAS unsigned*)(shm + LDS_BYTES - 16);
    unsigned* xbar = (unsigned*)(p_arg.ws + WS_BAR);
    if (tidx() == 0) { xst[0] = 0u; xst[1] = 0u; }
    if (blockIdx.x == 0) for (int i = tidx(); i < XCD_BAR_WORDS; i += 512) xbar[i] = 0u;
    XcdBarrier xb; xb.bar = xbar; xb.x = 0u; xb.st = xst;
    const int ph_lo = p_arg.ph_lo, ph_hi = p_arg.ph_hi;
    for (int ph = ph_lo; ph < ph_hi; ++ph) {
        KP p = (KP)__builtin_amdgcn_kernarg_segment_ptr(); asm volatile("" : "+s"(p));
        unsigned char* ws = p->ws;
        int kind, arg = 0;
        switch (ph) {
            case 0: kind = 0; break;            case 1: kind = 1; break;
            case 2: kind = 2; arg = 0; break;   case 3: kind = 3; arg = 0; break;   case 4: kind = 4; arg = 0; break;
            case 5: kind = 2; arg = 1; break;   case 6: kind = 5; break;            case 7: kind = 6; break;   case 8: kind = 7; break;   case 9: kind = 8; break;
            case 10: kind = 2; arg = 2; break;  case 11: kind = 3; arg = 1; break;  case 12: kind = 4; arg = 1; break;
            case 13: kind = 2; arg = 3; break;  case 14: kind = 3; arg = 2; break;  case 15: kind = 4; arg = 2; break;
            case 16: kind = 2; arg = 4; break;  case 17: kind = 9; break;           case 18: kind = 10; break;  case 19: kind = 11; break;  case 20: kind = 12; break;
            case 21: kind = 2; arg = 5; break;  case 22: kind = 3; arg = 3; break;  case 23: kind = 4; arg = 3; break;
            default: kind = 2; arg = 6; break;
        }
        const bf16_t* gA = nullptr; const bf16_t* gB = nullptr; int gM = TT, gN = 1024, gK = 1024; EpiAny ge{0, nullptr, nullptr, 1024, nullptr}; int gsplit = 0;
        if (kind == 1) { gA = (const bf16_t*)(ws + WS_AADA); gB = (const bf16_t*)(ws + WS_ADA); gM = 256; gN = NMOD; ge = EpiAny{0, ws + WS_MOD, nullptr, NMOD, p->in[I_ADAB]}; }
        else if (kind == 3) { gA = (const bf16_t*)(ws + WS_H); gB = (const bf16_t*)(ws + WS_FIN + (size_t)arg * SZ_FIN); gN = 5632; ge = EpiAny{1, ws + WS_A2, nullptr, 2816, nullptr}; }
        else if (kind == 4) { gA = (const bf16_t*)(ws + WS_A2); gB = (const bf16_t*)(ws + WS_FOUT + (size_t)arg * SZ_FOUT); gK = 2816; gsplit = 11; ge = EpiAny{0, ws + WS_Y, ws + WS_SLAB, 1024, nullptr}; }
        else if (kind == 8) { gA = (const bf16_t*)(ws + WS_Z); gB = (const bf16_t*)(ws + WS_EOUT); gsplit = 4; ge = EpiAny{0, ws + WS_Y, ws + WS_SLAB, 1024, nullptr}; }
        else if (kind == 12) { gA = (const bf16_t*)(ws + WS_Z); gB = (const bf16_t*)(ws + WS_OOUT); gsplit = 4; ge = EpiAny{0, ws + WS_Y, ws + WS_SLAB, 1024, nullptr}; }
        else if (kind == 5) { gA = (const bf16_t*)(ws + WS_H); gB = (const bf16_t*)(ws + WS_EIN); gN = 1792; ge = EpiAny{3, ws + WS_QKV, ws + WS_XGR, 768, nullptr}; }
        else if (kind == 9) { gA = (const bf16_t*)(ws + WS_H); gB = (const bf16_t*)(ws + WS_OIN); gN = 4096; ge = EpiAny{2, ws + WS_QFVG, nullptr, 4096, nullptr}; }
#ifndef PH_REP
#define PH_REP 0u
#endif
        const int nrep = ((PH_REP >> ph) & 1u) ? 2 : 1;
        for (int rep = 0; rep < nrep; ++rep) {
        if (gA) { PHX(1, run_gemm(shm, gA, gB, gM, gN, gK, ge, gsplit)); }
        else if (kind == 0) { PHX(0, phase_convert(p, shm)); }
        else if (kind == 2) { PHX(2, phase_rowop(p, arg)); }
        else if (kind == 6) { PHX(6, phase_mix_a(p, shm)); }
        else if (kind == 7) { PHX(7, phase_mix_b(p, shm)); }
        else if (kind == 10) { PHX(10, phase_hgrn(p, shm)); }
        else if (kind == 11) { PHX(11, phase_znorm(p)); }
        }
        if (ph + 1 < ph_hi) {
            if (ph == ph_lo) { grid.sync(); xb = xcd_barrier_post(xbar, xst); }
            else xcd_barrier(xb);
        }
    }
}

extern "C" void kernel_launch(void* const* d_in, const int* in_sizes, int n_in, void* d_out, int out_size, void* d_ws, size_t ws_size, hipStream_t stream) {
    static int grid = 0;
    if (grid == 0) {
        if (n_in != N_INPUTS || out_size != 39862272 || ws_size < WS_END) { fprintf(stderr, "kernel_launch: unexpected shapes: n_in %d out %d ws %zu (need %zu)\n", n_in, out_size, ws_size, (size_t)WS_END); grid = -1; return; }
        int dev = 0, cus = 0, per_cu = 0;
        hipGetDevice(&dev); hipDeviceGetAttribute(&cus, hipDeviceAttributeMultiprocessorCount, dev);
        if (hipFuncSetAttribute((const void*)hybrid_fwd, hipFuncAttributeMaxDynamicSharedMemorySize, LDS_BYTES) != hipSuccess) { fprintf(stderr, "kernel_launch: hipFuncSetAttribute failed\n"); grid = -1; return; }
        hipOccupancyMaxActiveBlocksPerMultiprocessor(&per_cu, (const void*)hybrid_fwd, 512, LDS_BYTES);
        (void)hipGetLastError();
        if (per_cu < 1) per_cu = 1;
        grid = cus;
        fprintf(stderr, "kernel_launch: cus %d per_cu %d grid %d ws %zu\n", cus, per_cu, grid, ws_size);
    }
    if (grid < 0) return;
    Params p{};
    for (int i = 0; i < N_INPUTS; ++i) p.in[i] = (const float*)d_in[i];
    p.out = (float*)d_out; p.ws = (unsigned char*)d_ws; p.ph_lo = 0; p.ph_hi = N_PHASES;
    void* args[] = {&p};
    hipError_t e = hipLaunchCooperativeKernel((const void*)hybrid_fwd, dim3(grid), dim3(512), args, LDS_BYTES, stream);
    if (e != hipSuccess) fprintf(stderr, "cooperative launch failed: %s (grid %d)\n", hipGetErrorString(e), grid);
}
```

```cpp
#include <hip/hip_runtime.h>
#include <hip/hip_cooperative_groups.h>
#include <cstdio>
namespace cg = cooperative_groups;
__device__ __forceinline__ int tidx() { int t = threadIdx.x; asm volatile("" : "+v"(t)); return t; }
namespace pg8 {
#define PG8_LAS __attribute__((address_space(3)))
typedef unsigned short bf16_t;
typedef short bf16x8 __attribute__((ext_vector_type(8)));
typedef float f32x4 __attribute__((ext_vector_type(4)));
typedef unsigned u32x4 __attribute__((ext_vector_type(4)));
constexpr int BM = 256, BK = 64, HALF = 128, HTB = HALF * BK * 2  , STAGE_BYTES = 8 * HTB, NXCD = 8, WGM = 8;

__host__ __device__ __forceinline__ int lds_byte(int r, int c) { const int st = (r >> 4) * 2 + (c >> 5), rr = r & 15, cc = c & 31, ob = rr * 64 + cc * 2; return st * 1024 + (ob ^ (((ob >> 9) & 1) << 5)); }
__host__ __device__ __forceinline__ void stage_rc(int b, int& R, int& C) { const int st = b / 1024, sb = b % 1024, swz = sb ^ (((sb >> 9) & 1) << 5); R = (st >> 1) * 16 + swz / 64; C = (st & 1) * 32 + (swz % 64) / 2; }
__host__ __device__ __forceinline__ int perm32(int rho) { const int n = rho >> 4, i = rho & 15; return 8 * (i >> 2) + 4 * n + (i & 3); }

struct Unit { int pm, pn, k0, nt, slab; };
struct Gemm { const bf16_t* A; const bf16_t* Bt; int M, N, K; };

struct StaticOrder {
    int nM, nN, nwg, G, c, ntk, split;
    __host__ __device__ void init(int M, int N, int G_, int c_, int K_ = 1024, int split_ = 0) { nM = M / BM; nN = N / BM; nwg = nM * nN; G = G_; c = c_; ntk = K_ / BK; split = split_; }
    __host__ __device__ bool next(int i, Unit& u) const {
        const long L = (long)i * G + c;
        u.k0 = 0; u.nt = ntk; u.slab = -1;
        if (split > 0) {
            if (L < 256) { const int x = (int)L & 7, j = (int)L >> 3; u.pm = 8 * x + (j & 7); u.pn = j >> 3; return true; }
            const int s = (int)L - 256; if (s >= 8 * split) return false;
            const int tile = s / split, sl = s - tile * split; u.pm = 64 + (tile >> 2); u.pn = tile & 3; u.nt = ntk / split; u.k0 = sl * u.nt * BK; u.slab = sl; return true;
        }
        if (L >= nwg) return false;
        int wgid = (int)L; { const int q = nwg / NXCD, r = nwg % NXCD, xcd = wgid % NXCD, off = wgid / NXCD; wgid = (xcd < r ? xcd * (q + 1) : r * (q + 1) + (xcd - r) * q) + off; }
        const int nig = WGM * nN, gid = wgid / nig, fm = gid * WGM, gsz = (nM - fm) < WGM ? (nM - fm) : WGM;
        u.pm = fm + ((wgid % nig) % gsz); u.pn = (wgid % nig) / gsz; return true;
    }
    __device__ __forceinline__ void a_ready(const Unit&) const {}
    __device__ __forceinline__ void done(const Unit&) const {}
};
typedef __bf16 hwbf16x2 __attribute__((ext_vector_type(2))); typedef float hwf32x2 __attribute__((ext_vector_type(2)));
__device__ __forceinline__ unsigned cvt_pk_bf16(float lo, float hi) { const hwf32x2 v = {lo, hi}; const hwbf16x2 r = __builtin_convertvector(v, hwbf16x2); return __builtin_bit_cast(unsigned, r); }
template <class Epi, class Sched, bool STAMP = false>
__device__ __forceinline__ void gemm_phase(PG8_LAS unsigned char* lds, const Gemm g, const Sched& S, const Epi& E, unsigned long long* stamps) {
    const int tid = tidx(), wid = __builtin_amdgcn_readfirstlane(tid >> 6), lane = tid & 63, wr = wid >> 2, wc = wid & 3, fr = lane & 15, fq = lane >> 4;
    const int K = g.K;
    int ts_lo = 0, ts_hi = 0, nts = 0; const unsigned long long rt_entry = STAMP ? (unsigned long long)wall_clock64() : 0ull;
#define PG8_STAMP() do { if (STAMP && wid == 0 && nts < 64) { const unsigned long long _c = (unsigned long long)clock64(); \
        ts_lo = (lane == nts) ? (int)(unsigned)_c : ts_lo; ts_hi = (lane == nts) ? (int)(unsigned)(_c >> 32) : ts_hi; ++nts; } } while (0)
    PG8_STAMP();
    unsigned voffA[2], voffB[2];
#pragma unroll
    for (int i = 0; i < 2; ++i) { int R, C; stage_rc(tid * 16 + i * 8192, R, C); const int Rb = Epi::PERM ? ((R & ~31) + perm32(R & 31)) : R;
        voffA[i] = (unsigned)(R * K + C) * 2u; voffB[i] = (unsigned)(Rb * K + C) * 2u; }
    const size_t kstep = (size_t)(BK * 2);
    const size_t hstep = (size_t)HALF * K * 2;
    const size_t tstep = 2 * hstep;
    const unsigned ldsw = (unsigned)wid * 1024u;
    const int aoff = lds_byte(wr * 64 + fr, fq * 8), boff = lds_byte(wc * 32 + fr, fq * 8);
#define PG8_SA(b, h) (((b) * 2 + (h)) * HTB)
#define PG8_SB(b, h) ((4 + (b) * 2 + (h)) * HTB)
#define PG8_STAGE(bufoff, gbase, voff) do { _Pragma("unroll") for (int _i = 0; _i < 2; ++_i) \
        __builtin_amdgcn_global_load_lds((const unsigned*)((const char*)(gbase) + (voff)[_i]), (PG8_LAS unsigned*)(lds + (bufoff) + ldsw + _i * 8192), 16, 0, 0); } while (0)
#define PG8_LDA(dst, b, h) do { _Pragma("unroll") for (int m = 0; m < 4; ++m) _Pragma("unroll") for (int k = 0; k < 2; ++k) dst[m][k] = *(const PG8_LAS bf16x8*)(lds + PG8_SA(b, h) + aoff + m * 2048 + k * 1024); } while (0)
#define PG8_LDB(dst, b, h) do { _Pragma("unroll") for (int n = 0; n < 2; ++n) _Pragma("unroll") for (int k = 0; k < 2; ++k) dst[n][k] = *(const PG8_LAS bf16x8*)(lds + PG8_SB(b, h) + boff + n * 2048 + k * 1024); } while (0)
#define PG8_MMA(ai, bj, At, Bt) do { __builtin_amdgcn_s_setprio(1); _Pragma("unroll") for (int m = 0; m < 4; ++m) _Pragma("unroll") for (int n = 0; n < 2; ++n) _Pragma("unroll") for (int k = 0; k < 2; ++k) \
        acc[ai][bj][m][n] = __builtin_amdgcn_mfma_f32_16x16x32_bf16(Bt[n][k], At[m][k], acc[ai][bj][m][n], 0, 0, 0); __builtin_amdgcn_s_setprio(0); } while (0)
#define PG8_WAIT_V(n) asm volatile("s_waitcnt vmcnt(" #n ")" ::: "memory")
#define PG8_WAIT_L(n) asm volatile("s_waitcnt lgkmcnt(" #n ")" ::: "memory")
#define PG8_BAR __builtin_amdgcn_s_barrier()
#define PG8_SCHED __builtin_amdgcn_sched_barrier(0)
    Unit cur, nxt; int ui = 0;
    if (!S.next(0, cur)) return;
    f32x4 acc[2][2][4][2];
#pragma unroll
    for (int a = 0; a < 2; ++a)
#pragma unroll
        for (int b = 0; b < 2; ++b)
#pragma unroll
            for (int m = 0; m < 4; ++m)
#pragma unroll
                for (int n = 0; n < 2; ++n) acc[a][b][m][n] = (f32x4){0.f, 0.f, 0.f, 0.f};
    bf16x8 At[4][2], B0[2][2], B1[2][2];
    const char* cA = (const char*)g.A + (size_t)cur.pm * tstep + (size_t)cur.k0 * 2; const char* cB = (const char*)g.Bt + (size_t)cur.pn * tstep + (size_t)cur.k0 * 2;
    S.a_ready(cur);
    PG8_STAGE(PG8_SB(0, 0), cB, voffB); PG8_STAGE(PG8_SA(0, 0), cA, voffA); PG8_STAGE(PG8_SB(0, 1), cB + hstep, voffB); PG8_STAGE(PG8_SA(0, 1), cA + hstep, voffA);
    if (wr == 1) PG8_BAR;
    PG8_WAIT_V(4); PG8_BAR;
    PG8_STAGE(PG8_SB(1, 0), cB + kstep, voffB); PG8_STAGE(PG8_SA(1, 0), cA + kstep, voffA); PG8_STAGE(PG8_SB(1, 1), cB + hstep + kstep, voffB);
    PG8_WAIT_V(6); PG8_BAR;
    PG8_STAMP();
    for (;;) {
        const bool has_next = S.next(ui + 1, nxt);
        const char* nA = has_next ? (const char*)g.A + (size_t)nxt.pm * tstep + (size_t)nxt.k0 * 2 : cA; const char* nB = has_next ? (const char*)g.Bt + (size_t)nxt.pn * tstep + (size_t)nxt.k0 * 2 : cB;
        const int nt = cur.nt;
        for (int t = 0; t < nt; t += 2) {
            const bool last = (t == nt - 2);
            const char* a1 = cA + (size_t)(t + 1) * kstep;
            const char* a2 = last ? nA : cA + (size_t)(t + 2) * kstep; const char* b2 = last ? nB : cB + (size_t)(t + 2) * kstep;
            const char* a3 = a2 + kstep; const char* b3 = b2 + kstep;
            if (last && has_next) S.a_ready(nxt);
            PG8_LDB(B0, 0, 0); PG8_SCHED; PG8_LDA(At, 0, 0); PG8_STAGE(PG8_SA(1, 1), a1 + hstep, voffA);
            PG8_WAIT_L(8); PG8_BAR; PG8_WAIT_L(0); PG8_MMA(0, 0, At, B0); PG8_BAR; PG8_SCHED;
            PG8_LDB(B1, 0, 1); PG8_STAGE(PG8_SB(0, 0), b2, voffB);
            PG8_BAR; PG8_WAIT_L(0); PG8_MMA(0, 1, At, B1); PG8_BAR;
            PG8_LDA(At, 0, 1); PG8_STAGE(PG8_SA(0, 0), a2, voffA);
            PG8_BAR; PG8_WAIT_L(0); PG8_MMA(1, 0, At, B0); PG8_BAR; PG8_SCHED;
            PG8_STAGE(PG8_SB(0, 1), b2 + hstep, voffB);
            PG8_WAIT_V(6); PG8_BAR; PG8_MMA(1, 1, At, B1); PG8_BAR;
            PG8_LDB(B0, 1, 0); PG8_SCHED; PG8_LDA(At, 1, 0); PG8_STAGE(PG8_SA(0, 1), a2 + hstep, voffA);
            PG8_WAIT_L(8); PG8_BAR; PG8_WAIT_L(0); PG8_MMA(0, 0, At, B0); PG8_BAR; PG8_SCHED;
            PG8_LDB(B1, 1, 1); PG8_STAGE(PG8_SB(1, 0), b3, voffB);
            PG8_BAR; PG8_WAIT_L(0); PG8_MMA(0, 1, At, B1); PG8_BAR;
            PG8_LDA(At, 1, 1); PG8_STAGE(PG8_SA(1, 0), a3, voffA);
            PG8_BAR; PG8_WAIT_L(0); PG8_MMA(1, 0, At, B0); PG8_BAR; PG8_SCHED;
            PG8_STAGE(PG8_SB(1, 1), b3 + hstep, voffB);
            PG8_WAIT_V(6); PG8_BAR; PG8_MMA(1, 1, At, B1); PG8_BAR;
        }
        PG8_STAMP();
        if constexpr (!Epi::AFTER_DRAIN) { E(acc, cur, wr, wc, fr, fq); S.done(cur); }
        PG8_STAMP();
        if (!has_next) break;
#pragma unroll
        for (int a = 0; a < 2; ++a)
#pragma unroll
            for (int b = 0; b < 2; ++b)
#pragma unroll
                for (int m = 0; m < 4; ++m)
#pragma unroll
                    for (int n = 0; n < 2; ++n) acc[a][b][m][n] = (f32x4){0.f, 0.f, 0.f, 0.f};
        cur = nxt; cA = nA; cB = nB; ++ui;
    }
    PG8_WAIT_V(0);
    if (wr == 0) PG8_BAR;
    PG8_BAR;
    if constexpr (Epi::AFTER_DRAIN) { E.fused(acc, cur, wr, wc, fr, fq, lds, wid, lane); S.done(cur); }
    PG8_STAMP();
    if (STAMP && wid == 0) { stamps[lane] = lane < nts ? (((unsigned long long)(unsigned)ts_hi << 32) | (unsigned)ts_lo) : 0ull;
        if (lane == 62) stamps[62] = rt_entry; if (lane == 63) stamps[63] = (unsigned long long)wall_clock64(); }
#undef PG8_STAMP
#undef PG8_SA
#undef PG8_SB
#undef PG8_STAGE
#undef PG8_LDA
#undef PG8_LDB
#undef PG8_MMA
#undef PG8_WAIT_V
#undef PG8_WAIT_L
#undef PG8_BAR
#undef PG8_SCHED
}
}
#define XB_TMO      128
#define XB_XCNT(j)  (256  + 64 * (j))
#define XB_XSUB(j)  (1280 + 64 * (j))
#define XB_XGEN(j)  (2304 + 64 * (j))
#define XB_TOP      3328
#define XB_TOPGEN   3392
#define XCD_BAR_WORDS 3456
#define XB_SPIN_CAP (1u << 18)
#define LAS __attribute__((address_space(3)))

__device__ __forceinline__ unsigned xb_ld(unsigned* p)              { return __hip_atomic_load(p, __ATOMIC_RELAXED, __HIP_MEMORY_SCOPE_AGENT); }
__device__ __forceinline__ unsigned xb_add(unsigned* p, unsigned v) { return __hip_atomic_fetch_add(p, v, __ATOMIC_RELAXED, __HIP_MEMORY_SCOPE_AGENT); }
__device__ __forceinline__ unsigned xb_xcc_id() { return (unsigned)__builtin_amdgcn_s_getreg((3 << 11) | 20) & 0xFu; }
#define XB_SPIN(cond, bar) do { unsigned _sp = 0; while (cond) { __builtin_amdgcn_s_sleep(1); \
    if ((++_sp & 255u) == 0u) { if (xb_ld(&(bar)[XB_TMO])) break; if (_sp > XB_SPIN_CAP) { atomicAdd(&(bar)[XB_TMO], 1u); break; } } } } while (0)

struct XcdBarrier {
    unsigned* bar; unsigned x;
    volatile LAS unsigned* st;
};

__device__ __forceinline__ XcdBarrier xcd_barrier_post(unsigned* bar, volatile LAS unsigned* st) {
    XcdBarrier b; b.bar = bar; b.x = xb_xcc_id(); b.st = st;
    if (tidx() == 0) (void)xb_add(&bar[XB_XCNT(b.x)], 1u);
    return b;
}
__device__ __forceinline__ void xcd_barrier_complete(unsigned* bar, unsigned x, unsigned& nloc, unsigned& nx) {
    const unsigned G = gridDim.x * gridDim.y * gridDim.z;
    unsigned sum, cnt, mine, sp = 0u;
    for (;;) {
        sum = 0u; cnt = 0u; mine = 0u;
#pragma unroll
        for (unsigned j = 0; j < 16; ++j) { const unsigned c = xb_ld(&bar[XB_XCNT(j)]); sum += c; cnt += (c > 0u) ? 1u : 0u; mine = (j == x) ? c : mine; }
        if (sum == G) break;
        __builtin_amdgcn_s_sleep(1);
        if ((++sp & 255u) == 0u) { if (xb_ld(&bar[XB_TMO])) break; if (sp > XB_SPIN_CAP) { atomicAdd(&bar[XB_TMO], 1u); break; } }
    }
    nloc = mine > 0u ? mine : 1u; nx = cnt > 0u ? cnt : 1u;
}

__device__ __forceinline__ void xcd_barrier(const XcdBarrier& b) {
    asm volatile("s_waitcnt vmcnt(0)" ::: "memory");
    __syncthreads();
    if (tidx() == 0) {
        unsigned* bar = b.bar;
        __builtin_amdgcn_s_waitcnt(0);
        unsigned nloc = b.st[0], nx = b.st[1];
        if (nloc == 0u) { xcd_barrier_complete(bar, b.x, nloc, nx); b.st[0] = nloc; b.st[1] = nx; }
        const unsigned old = xb_add(&bar[XB_XSUB(b.x)], 1u);
        const unsigned gen = old / nloc;
        if (old + 1u == (gen + 1u) * nloc) {
            __builtin_amdgcn_fence(__ATOMIC_RELEASE, "agent");
            asm volatile("s_waitcnt vmcnt(0)" ::: "memory");
            const unsigned og = xb_add(&bar[XB_TOP], 1u);
            const unsigned tg = og / nx;
            if (og + 1u == (tg + 1u) * nx) xb_add(&bar[XB_TOPGEN], 1u);
            else XB_SPIN(xb_ld(&bar[XB_TOPGEN]) == tg, bar);
            __builtin_amdgcn_fence(__ATOMIC_ACQUIRE, "agent");
            xb_add(&bar[XB_XGEN(b.x)], 1u);
            asm volatile("s_waitcnt vmcnt(0)" ::: "memory");
        } else {
            XB_SPIN(xb_ld(&bar[XB_XGEN(b.x)]) == gen, bar);
            __builtin_amdgcn_fence(__ATOMIC_ACQUIRE, "agent");
            asm volatile("s_waitcnt vmcnt(0)" ::: "memory");
        }
    }
    __syncthreads();
}


using pg8::bf16_t; using pg8::bf16x8; using pg8::f32x4; using pg8::u32x4; using pg8::Unit; using pg8::cvt_pk_bf16;
typedef unsigned u32x2 __attribute__((ext_vector_type(2)));

constexpr int TP = 16384, TT = 16896, NMOD = 18432;
enum { I_XP = 0, I_XS, I_CP, I_CS, I_CK, I_CV, I_SCONV, I_SH, I_SS, I_NPRE, I_NPOST, I_ADAW, I_ADAB, I_F1IN, I_F1OUT, I_F2IN, I_F2OUT,
       I_EIN, I_EOUT, I_SINK, I_CONVW, I_CONVB, I_WA, I_BA, I_WX, I_BX, I_LAM, I_OIN, I_OOUT, I_LB, I_GN, N_INPUTS };
constexpr size_t O_KWP = 17301504, O_VWP = O_KWP + 131072, O_CONVP = O_VWP + 131072, O_HP = O_CONVP + 12288, O_SP = O_HP + 4096,
                 O_KWS = O_SP + 1048576, O_VWS = O_KWS + 2097152, O_CONVS = O_VWS + 2097152, O_HS = O_CONVS + 196608, O_SS = O_HS + 65536;
constexpr size_t SZ_FIN = 5632ull * 1024 * 2, SZ_FOUT = 1024ull * 2816 * 2;
constexpr size_t WS_FIN = 0, WS_FOUT = WS_FIN + 4 * SZ_FIN, WS_EIN = WS_FOUT + 4 * SZ_FOUT, WS_EOUT = WS_EIN + 1792ull * 1024 * 2,
                 WS_OIN = WS_EOUT + 1024ull * 1024 * 2, WS_OOUT = WS_OIN + 4096ull * 1024 * 2, WS_ADA = WS_OOUT + 1024ull * 1024 * 2,
                 WS_AADA = WS_ADA + 18432ull * 1024 * 2, WS_MOD = WS_AADA + 256ull * 1024 * 2, WS_ROPE = WS_MOD + 256ull * 18432 * 4,
                 WS_H = WS_ROPE + 2052ull * 16 * 4, WS_A2 = WS_H + 16896ull * 1024 * 2, WS_Y = WS_A2 + 16896ull * 2816 * 2,
                 WS_BAR = WS_Y + 16896ull * 1024 * 4, WS_SLAB = WS_BAR + 16384, WS_END = WS_SLAB + 11ull * 512 * 1024 * 4;
constexpr size_t WS_QKV = WS_A2, WS_XGR = WS_A2 + 16896ull * 768 * 2, WS_LA = WS_Y, WS_LB = WS_Y + 16896ull * 512 * 4, WS_Z = WS_H, WS_QFVG = WS_A2;
constexpr int LDS_BYTES = 147456;

struct Params { const float* in[N_INPUTS]; float* out; unsigned char* ws; int ph_lo, ph_hi; };
typedef const __attribute__((address_space(4))) Params* KP;

__device__ __forceinline__ float bf_lo(unsigned u) { return __uint_as_float(u << 16); }
__device__ __forceinline__ float bf_hi(unsigned u) { return __uint_as_float(u & 0xffff0000u); }
__device__ __forceinline__ float bf1(bf16_t u) { return __uint_as_float(((unsigned)u) << 16); }
__device__ __forceinline__ bf16_t f2bf(float f) { return (bf16_t)(cvt_pk_bf16(f, 0.f) & 0xffffu); }
__device__ __forceinline__ float sigmoidf_(float x) { return __builtin_amdgcn_rcpf(1.f + __expf(-x)); }
__device__ __forceinline__ float siluf_(float x) { return x * __builtin_amdgcn_rcpf(1.f + __expf(-x)); }
__device__ __forceinline__ float wave_sum(float v) {
#pragma unroll
    for (int o = 32; o > 0; o >>= 1) v += __shfl_xor(v, o);
    return v;
}

struct EpiF32 {
    static constexpr bool PERM = false, AFTER_DRAIN = false;
    float* C; int ldc; const float* bias;
    __device__ __forceinline__ void operator()(const f32x4 (&acc)[2][2][4][2], const Unit& u, int wr, int wc, int fr, int fq) const {
        const int row0 = u.pm * 256 + wr * 64 + fr, col0 = u.pn * 256 + wc * 32 + 4 * fq;
        f32x4 bv[2][2];
#pragma unroll
        for (int bj = 0; bj < 2; ++bj)
#pragma unroll
            for (int n = 0; n < 2; ++n) bv[bj][n] = bias ? *(const f32x4*)(bias + col0 + bj * 128 + n * 16) : (f32x4){0.f, 0.f, 0.f, 0.f};
#pragma unroll
        for (int ai = 0; ai < 2; ++ai)
#pragma unroll
            for (int m = 0; m < 4; ++m) { float* rowp = C + (size_t)(row0 + ai * 128 + m * 16) * ldc + col0;
#pragma unroll
                for (int bj = 0; bj < 2; ++bj)
#pragma unroll
                    for (int n = 0; n < 2; ++n) *(f32x4*)(rowp + bj * 128 + n * 16) = acc[ai][bj][m][n] + bv[bj][n]; }
    }
};
struct EpiSwiglu {
    static constexpr bool PERM = false, AFTER_DRAIN = false;
    bf16_t* O;
    __device__ __forceinline__ void operator()(const f32x4 (&acc)[2][2][4][2], const Unit& u, int wr, int wc, int fr, int fq) const {
        const int row0 = u.pm * 256 + wr * 64 + fr, col0 = u.pn * 128 + wc * 16 + 4 * fq;
#pragma unroll
        for (int ai = 0; ai < 2; ++ai)
#pragma unroll
            for (int m = 0; m < 4; ++m) { bf16_t* rowp = O + (size_t)(row0 + ai * 128 + m * 16) * 2816 + col0;
#pragma unroll
                for (int bj = 0; bj < 2; ++bj) { const f32x4 g = acc[ai][bj][m][0], v = acc[ai][bj][m][1];
                    u32x2 w; w.x = cvt_pk_bf16(siluf_(g[0]) * v[0], siluf_(g[1]) * v[1]); w.y = cvt_pk_bf16(siluf_(g[2]) * v[2], siluf_(g[3]) * v[3]);
                    *(u32x2*)(rowp + bj * 64) = w; } }
    }
};
struct EpiBf16 {
    static constexpr bool PERM = false, AFTER_DRAIN = false;
    bf16_t* O; int ldc;
    __device__ __forceinline__ void operator()(const f32x4 (&acc)[2][2][4][2], const Unit& u, int wr, int wc, int fr, int fq) const {
        const int row0 = u.pm * 256 + wr * 64 + fr, col0 = u.pn * 256 + wc * 32 + 4 * fq;
#pragma unroll
        for (int ai = 0; ai < 2; ++ai)
#pragma unroll
            for (int m = 0; m < 4; ++m) { bf16_t* rowp = O + (size_t)(row0 + ai * 128 + m * 16) * ldc + col0;
#pragma unroll
                for (int bj = 0; bj < 2; ++bj)
#pragma unroll
                    for (int n = 0; n < 2; ++n) { const f32x4 v = acc[ai][bj][m][n]; u32x2 w; w.x = cvt_pk_bf16(v[0], v[1]); w.y = cvt_pk_bf16(v[2], v[3]);
                        *(u32x2*)(rowp + bj * 128 + n * 16) = w; } }
    }
};
struct EpiEvenIn {
    static constexpr bool PERM = false, AFTER_DRAIN = false;
    bf16_t* QKV; float* XGR;
    __device__ __forceinline__ void operator()(const f32x4 (&acc)[2][2][4][2], const Unit& u, int wr, int wc, int fr, int fq) const {
        if (u.pn < 3) { EpiBf16 e{QKV, 768}; e(acc, u, wr, wc, fr, fq); }
        else { Unit u2 = u; u2.pn = u.pn - 3; EpiF32 e{XGR, 1024, nullptr}; e(acc, u2, wr, wc, fr, fq); }
    }
};


struct EpiAny {
    static constexpr bool PERM = false, AFTER_DRAIN = false;
    int mode; void* o1; void* o2; int ldc; const float* bias;
    __device__ __forceinline__ void operator()(const f32x4 (&acc)[2][2][4][2], const Unit& u, int wr, int wc, int fr, int fq) const {
        if (mode == 0) { float* C = u.slab >= 0 ? (float*)o2 + (size_t)u.slab * 524288 - (size_t)16384 * 1024 : (float*)o1; EpiF32 e{C, ldc, bias}; e(acc, u, wr, wc, fr, fq); }
        else if (mode == 1) { EpiSwiglu e{(bf16_t*)o1}; e(acc, u, wr, wc, fr, fq); }
        else if (mode == 2) { EpiBf16 e{(bf16_t*)o1, ldc}; e(acc, u, wr, wc, fr, fq); }
        else if (mode == 4) { if (u.slab >= 0) { EpiF32 e{(float*)o2 + (size_t)u.slab * 524288 - (size_t)16384 * 1024, 1024, nullptr}; e(acc, u, wr, wc, fr, fq); } else { EpiBf16 e{(bf16_t*)o1, 1024}; e(acc, u, wr, wc, fr, fq); } }
        else { EpiEvenIn e{(bf16_t*)o1, (float*)o2}; e(acc, u, wr, wc, fr, fq); }
    }
};

__device__ void phase_convert(KP p, unsigned char* lds) {
    float* tile = (float*)lds;
    const int tid = tidx();
    constexpr int NJ = 18;
    int total = 0;
    const int tj[4] = {16 * 88, 44 * 16, 0, 0};
    (void)tj;
    total = 4 * 1408 + 4 * 704 + 448 + 256 + 1024 + 256 + 6 * 768;
    for (int g = blockIdx.x; g < total; g += gridDim.x) {
        int r = g, job = 0;
        const float* src; bf16_t* dst; int K, N, perm = 0;
        if (r < 4 * 1408) { job = r / 1408; r -= job * 1408; const int l = job >> 1, second = job & 1;
            src = p->in[second ? I_F2IN : I_F1IN] + (size_t)l * 1024 * 5632; dst = (bf16_t*)(p->ws + WS_FIN + (size_t)job * SZ_FIN); K = 1024; N = 5632; perm = 1; }
        else if ((r -= 4 * 1408) < 4 * 704) { job = r / 704; r -= job * 704; const int l = job >> 1, second = job & 1;
            src = p->in[second ? I_F2OUT : I_F1OUT] + (size_t)l * 2816 * 1024; dst = (bf16_t*)(p->ws + WS_FOUT + (size_t)job * SZ_FOUT); K = 2816; N = 1024; }
        else if ((r -= 4 * 704) < 448) { src = p->in[I_EIN]; dst = (bf16_t*)(p->ws + WS_EIN); K = 1024; N = 1792; }
        else if ((r -= 448) < 256) { src = p->in[I_EOUT]; dst = (bf16_t*)(p->ws + WS_EOUT); K = 1024; N = 1024; }
        else if ((r -= 256) < 1024) { src = p->in[I_OIN]; dst = (bf16_t*)(p->ws + WS_OIN); K = 1024; N = 4096; }
        else if ((r -= 1024) < 256) { src = p->in[I_OOUT]; dst = (bf16_t*)(p->ws + WS_OOUT); K = 1024; N = 1024; }
        else { r -= 256; job = r / 768; r -= job * 768; src = p->in[I_ADAW] + (size_t)job * 1024 * 3072; dst = (bf16_t*)(p->ws + WS_ADA + (size_t)job * 3072 * 1024 * 2); K = 1024; N = 3072; }
        const int ntn = N / 64, kt = r / ntn, nt = r - kt * ntn, k0 = kt * 64, n0 = nt * 64;
        __syncthreads();
#pragma unroll
        for (int i = 0; i < 2; ++i) { const int idx = tid + i * 512, rr = idx >> 4, c4 = (idx & 15) * 4;
            const float4 v = *(const float4*)(src + (size_t)(k0 + rr) * N + n0 + c4);
            float* t = tile + rr * 65 + c4; t[0] = v.x; t[1] = v.y; t[2] = v.z; t[3] = v.w; }
        __syncthreads();
        { const int n = tid >> 3, ks = (tid & 7) * 8; const float* t = tile + ks * 65 + n;
            u32x4 w; w.x = cvt_pk_bf16(t[0], t[65]); w.y = cvt_pk_bf16(t[130], t[195]); w.z = cvt_pk_bf16(t[260], t[325]); w.w = cvt_pk_bf16(t[390], t[455]);
            int c = n0 + n, drow = c;
            if (perm) { const int half = c >= 2816, cc = half ? c - 2816 : c; drow = (cc >> 4) * 32 + half * 16 + (cc & 15); }
            *(u32x4*)(dst + (size_t)drow * K + k0 + ks) = w; }
    }
    (void)NJ;
    bf16_t* aada = (bf16_t*)(p->ws + WS_AADA);
    for (int i = blockIdx.x * 512 + tid; i < 256 * 1024; i += gridDim.x * 512) { const int b = i >> 10, k = i & 1023;
        float v = 0.f; if (b < 8) v = siluf_(p->in[I_CP][b * 1024 + k]); else if (b < 136) v = siluf_(p->in[I_CS][(b - 8) * 1024 + k]);
        aada[i] = f2bf(v); }
    float* rope = (float*)(p->ws + WS_ROPE);
    for (int i = blockIdx.x * 512 + tid; i < 2052 * 8; i += gridDim.x * 512) { const int pi = i >> 3, f = i & 7;
        const float pos = (float)(pi < 2048 ? pi : 16384 + (pi - 2048));
        const float inv = powf(500000.0f, -(float)(2 * f) / 16.0f);
        const float ang = pos * inv; float s, c; sincosf(ang, &s, &c);
        rope[pi * 16 + f] = c; rope[pi * 16 + 8 + f] = s; }
}

__device__ void phase_rowop(KP p, int idx) {
    const int lane = tidx() & 63, wave = tidx() >> 6;
    float* X = p->out; const bf16_t* Y = (const bf16_t*)(p->ws + WS_Y); const float* MOD = (const float*)(p->ws + WS_MOD); bf16_t* H = (bf16_t*)(p->ws + WS_H);
    const int prev = idx - 1; const float rw = (prev % 3 == 1) ? 1.0f : 0.5f;
    for (int row = blockIdx.x * 8 + wave; row < TT; row += gridDim.x * 8) {
        const int b = row < TP ? (row >> 11) : 8 + ((row - TP) >> 2);
        float4 x[4];
        if (idx == 0) { const float* src = row < TP ? p->in[I_XP] + (size_t)row * 1024 : p->in[I_XS] + (size_t)(row - TP) * 1024;
#pragma unroll
            for (int i = 0; i < 4; ++i) x[i] = *(const float4*)(src + i * 256 + lane * 4); }
        else {
            float4 y[4]; float ss = 0.f;
            if (row >= TP) {
                const float* SL = (const float*)(p->ws + WS_SLAB) + (size_t)(row - TP) * 1024; const int ns = (prev % 3 == 1) ? 4 : 11;
#pragma unroll
                for (int i = 0; i < 4; ++i) y[i] = make_float4(0.f, 0.f, 0.f, 0.f);
                for (int s2 = 0; s2 < ns; ++s2) {
#pragma unroll
                    for (int i = 0; i < 4; ++i) { const float4 t = *(const float4*)(SL + (size_t)s2 * 524288 + i * 256 + lane * 4); y[i].x += t.x; y[i].y += t.y; y[i].z += t.z; y[i].w += t.w; } }
            }
#pragma unroll
            for (int i = 0; i < 4; ++i) { if (row < TP) { const u32x2 yw = *(const u32x2*)(Y + (size_t)row * 1024 + i * 256 + lane * 4); y[i] = make_float4(bf_lo(yw.x), bf_hi(yw.x), bf_lo(yw.y), bf_hi(yw.y)); } x[i] = *(const float4*)(X + (size_t)row * 1024 + i * 256 + lane * 4);
                ss += y[i].x * y[i].x + y[i].y * y[i].y + y[i].z * y[i].z + y[i].w * y[i].w; }
            ss = wave_sum(ss); const float inv = rsqrtf(ss * (1.0f / 1024.0f) + 1e-6f);
            const float* gate = MOD + (size_t)b * NMOD + prev * 3072 + 2048; const float* gp = p->in[I_NPOST] + prev * 1024;
#pragma unroll
            for (int i = 0; i < 4; ++i) { const float4 g = *(const float4*)(gate + i * 256 + lane * 4), q = *(const float4*)(gp + i * 256 + lane * 4);
                x[i].x += rw * (1.f + g.x) * (y[i].x * inv) * q.x; x[i].y += rw * (1.f + g.y) * (y[i].y * inv) * q.y;
                x[i].z += rw * (1.f + g.z) * (y[i].z * inv) * q.z; x[i].w += rw * (1.f + g.w) * (y[i].w * inv) * q.w; }
        }
#pragma unroll
        for (int i = 0; i < 4; ++i) *(float4*)(X + (size_t)row * 1024 + i * 256 + lane * 4) = x[i];
        if (idx < 6) {
            float ss = 0.f;
#pragma unroll
            for (int i = 0; i < 4; ++i) ss += x[i].x * x[i].x + x[i].y * x[i].y + x[i].z * x[i].z + x[i].w * x[i].w;
            ss = wave_sum(ss); const float inv = rsqrtf(ss * (1.0f / 1024.0f) + 1e-6f);
            const float* sh = MOD + (size_t)b * NMOD + idx * 3072; const float* gq = p->in[I_NPRE] + idx * 1024;
#pragma unroll
            for (int i = 0; i < 4; ++i) { const float4 s = *(const float4*)(sh + i * 256 + lane * 4), sc = *(const float4*)(sh + 1024 + i * 256 + lane * 4), q = *(const float4*)(gq + i * 256 + lane * 4);
                u32x2 w; w.x = cvt_pk_bf16((x[i].x * inv) * q.x * (1.f + sc.x) + s.x, (x[i].y * inv) * q.y * (1.f + sc.y) + s.y);
                w.y = cvt_pk_bf16((x[i].z * inv) * q.z * (1.f + sc.z) + s.z, (x[i].w * inv) * q.w * (1.f + sc.w) + s.w);
                *(u32x2*)(H + (size_t)row * 1024 + i * 256 + lane * 4) = w; }
        }
    }
}

__device__ __forceinline__ void rope16(u32x4& a, u32x4& b, const float* rt) {
    float x1[8], x2[8];
    x1[0] = bf_lo(a.x); x1[1] = bf_hi(a.x); x1[2] = bf_lo(a.y); x1[3] = bf_hi(a.y); x1[4] = bf_lo(a.z); x1[5] = bf_hi(a.z); x1[6] = bf_lo(a.w); x1[7] = bf_hi(a.w);
    x2[0] = bf_lo(b.x); x2[1] = bf_hi(b.x); x2[2] = bf_lo(b.y); x2[3] = bf_hi(b.y); x2[4] = bf_lo(b.z); x2[5] = bf_hi(b.z); x2[6] = bf_lo(b.w); x2[7] = bf_hi(b.w);
    float o1[8], o2[8];
#pragma unroll
    for (int i = 0; i < 8; ++i) { const float c = rt[i], s = rt[8 + i]; o1[i] = x1[i] * c - x2[i] * s; o2[i] = x2[i] * c + x1[i] * s; }
    a.x = cvt_pk_bf16(o1[0], o1[1]); a.y = cvt_pk_bf16(o1[2], o1[3]); a.z = cvt_pk_bf16(o1[4], o1[5]); a.w = cvt_pk_bf16(o1[6], o1[7]);
    b.x = cvt_pk_bf16(o2[0], o2[1]); b.y = cvt_pk_bf16(o2[2], o2[3]); b.z = cvt_pk_bf16(o2[4], o2[5]); b.w = cvt_pk_bf16(o2[6], o2[7]);
}
__device__ __forceinline__ void st_f32x8(float* dst, const u32x4 v) {
    *(float4*)dst = make_float4(bf_lo(v.x), bf_hi(v.x), bf_lo(v.y), bf_hi(v.y)); *(float4*)(dst + 4) = make_float4(bf_lo(v.z), bf_hi(v.z), bf_lo(v.w), bf_hi(v.w));
}

__device__ void attn_prompt_item(KP p, unsigned char* lds, int item) {
    const int b = item >> 5, n = (item >> 1) & 15, kvh = item & 1;
    bf16_t* Ks = (bf16_t*)lds;
    bf16_t* Vt = Ks + 256 * 72;
    bf16_t* Qs = Vt + 64 * 264;
    const bf16_t* QKV = (const bf16_t*)(p->ws + WS_QKV); const float* rope = (const float*)(p->ws + WS_ROPE);
    bf16_t* Z = (bf16_t*)(p->ws + WS_Z);
    const int tid = tidx();
    __syncthreads();
    {
        const int key = tid >> 1, dh = tid & 1, pos = n * 128 - 128 + key;
        u32x4 kk[4], vv[4];
        if (pos >= 0) { const bf16_t* src = QKV + (size_t)(b * 2048 + pos) * 768 + 512 + kvh * 64 + dh * 32;
#pragma unroll
            for (int i = 0; i < 4; ++i) { kk[i] = *(const u32x4*)(src + i * 8); vv[i] = *(const u32x4*)(src + 128 + i * 8); }
            if (dh == 0) rope16(kk[0], kk[1], rope + pos * 16);
        } else {
#pragma unroll
            for (int i = 0; i < 4; ++i) { kk[i] = (u32x4){0u, 0u, 0u, 0u}; vv[i] = kk[i]; } }
#pragma unroll
        for (int i = 0; i < 4; ++i) *(u32x4*)(Ks + key * 72 + dh * 32 + i * 8) = kk[i];
#pragma unroll
        for (int i = 0; i < 4; ++i) { const unsigned w[4] = {vv[i].x, vv[i].y, vv[i].z, vv[i].w};
#pragma unroll
            for (int j = 0; j < 4; ++j) { Vt[(dh * 32 + i * 8 + j * 2) * 264 + key] = (bf16_t)(w[j] & 0xffffu); Vt[(dh * 32 + i * 8 + j * 2 + 1) * 264 + key] = (bf16_t)(w[j] >> 16); } }
        if (n == 15 && key >= 128) { float* ko = p->out + O_KWP + ((size_t)(b * 128 + key - 128) * 2 + kvh) * 64 + dh * 32; float* vo = p->out + O_VWP + ((size_t)(b * 128 + key - 128) * 2 + kvh) * 64 + dh * 32;
#pragma unroll
            for (int i = 0; i < 4; ++i) { st_f32x8(ko + i * 8, kk[i]); st_f32x8(vo + i * 8, vv[i]); } }
    }
    {
        const int row = tid, g = row >> 7, qi = row & 127, pos = n * 128 + qi;
        const bf16_t* src = QKV + (size_t)(b * 2048 + pos) * 768 + (kvh * 4 + g) * 64;
        u32x4 q[8];
#pragma unroll
        for (int i = 0; i < 8; ++i) q[i] = *(const u32x4*)(src + i * 8);
        rope16(q[0], q[1], rope + pos * 16);
#pragma unroll
        for (int i = 0; i < 8; ++i) *(u32x4*)(Qs + row * 72 + i * 8) = q[i];
    }
    __syncthreads();
    const int w = tid >> 6, l = tid & 63, fr = l & 15, fq = l >> 4;
    const int head = kvh * 4 + (w >> 1);
    const float sink = p->in[I_SINK][head];
#pragma unroll 1
    for (int sb = 0; sb < 2; ++sb) {
        const int q0 = (w & 1) * 64 + sb * 32, kb = q0;
        const bf16_t* Qw = Qs + ((w >> 1) * 128 + q0) * 72;
        bf16x8 qf[2][2];
#pragma unroll
        for (int nt = 0; nt < 2; ++nt)
#pragma unroll
            for (int ks = 0; ks < 2; ++ks) qf[nt][ks] = *(const bf16x8*)(Qw + (nt * 16 + fr) * 72 + ks * 32 + fq * 8);
        f32x4 s[10][2];
#pragma unroll
        for (int mt = 0; mt < 10; ++mt) {
            bf16x8 kf[2];
#pragma unroll
            for (int ks = 0; ks < 2; ++ks) kf[ks] = *(const bf16x8*)(Ks + (kb + mt * 16 + fr) * 72 + ks * 32 + fq * 8);
#pragma unroll
            for (int nt = 0; nt < 2; ++nt) { f32x4 a = {0.f, 0.f, 0.f, 0.f};
                a = __builtin_amdgcn_mfma_f32_16x16x32_bf16(kf[0], qf[nt][0], a, 0, 0, 0);
                a = __builtin_amdgcn_mfma_f32_16x16x32_bf16(kf[1], qf[nt][1], a, 0, 0, 0); s[mt][nt] = a; }
        }
        bf16x8 pf[5][2];
#pragma unroll
        for (int nt = 0; nt < 2; ++nt) {
            const int qi = q0 + nt * 16 + fr;
            float m = sink;
#pragma unroll
            for (int mt = 0; mt < 10; ++mt)
#pragma unroll
                for (int r = 0; r < 4; ++r) { const int j = kb + mt * 16 + fq * 4 + r; const bool ok = (j > qi) && (j <= qi + 128) && (n > 0 || j >= 128);
                    const float v = ok ? s[mt][nt][r] * 0.125f : -INFINITY; s[mt][nt][r] = v; m = fmaxf(m, v); }
            m = fmaxf(m, __shfl_xor(m, 16)); m = fmaxf(m, __shfl_xor(m, 32));
            float sum = 0.f;
#pragma unroll
            for (int mt = 0; mt < 10; ++mt)
#pragma unroll
                for (int r = 0; r < 4; ++r) { const float e = __expf(s[mt][nt][r] - m); s[mt][nt][r] = e; sum += e; }
            sum += __shfl_xor(sum, 16); sum += __shfl_xor(sum, 32);
            const float rinv = 1.f / (sum + __expf(sink - m));
#pragma unroll
            for (int kp = 0; kp < 5; ++kp) { const f32x4 a = s[2 * kp][nt] * rinv, c = s[2 * kp + 1][nt] * rinv;
                u32x4 t; t.x = cvt_pk_bf16(a[0], a[1]); t.y = cvt_pk_bf16(a[2], a[3]); t.z = cvt_pk_bf16(c[0], c[1]); t.w = cvt_pk_bf16(c[2], c[3]);
                pf[kp][nt] = __builtin_bit_cast(bf16x8, t); }
        }
        f32x4 o[4][2];
#pragma unroll
        for (int dt = 0; dt < 4; ++dt) {
#pragma unroll
            for (int nt = 0; nt < 2; ++nt) o[dt][nt] = (f32x4){0.f, 0.f, 0.f, 0.f};
#pragma unroll
            for (int kp = 0; kp < 5; ++kp) { const bf16_t* vp = Vt + (dt * 16 + fr) * 264 + kb + kp * 32 + fq * 4;
                u32x4 t; const u32x2 lo = *(const u32x2*)vp, hi = *(const u32x2*)(vp + 16); t.x = lo.x; t.y = lo.y; t.z = hi.x; t.w = hi.y;
                const bf16x8 vf = __builtin_bit_cast(bf16x8, t);
#pragma unroll
                for (int nt = 0; nt < 2; ++nt) o[dt][nt] = __builtin_amdgcn_mfma_f32_16x16x32_bf16(vf, pf[kp][nt], o[dt][nt], 0, 0, 0); }
        }
#pragma unroll
        for (int nt = 0; nt < 2; ++nt) { const int tok = b * 2048 + n * 128 + q0 + nt * 16 + fr;
#pragma unroll
            for (int dt = 0; dt < 4; ++dt) { u32x2 wv; wv.x = cvt_pk_bf16(o[dt][nt][0], o[dt][nt][1]); wv.y = cvt_pk_bf16(o[dt][nt][2], o[dt][nt][3]);
                *(u32x2*)(Z + (size_t)tok * 1024 + head * 64 + dt * 16 + fq * 4) = wv; } }
    }
}

__device__ void attn_sample_item(KP p, unsigned char* lds, int item) {
    const int bs = item >> 1, kvh = item & 1;
    float* Kf = (float*)lds;
    float* Vf = Kf + 132 * 65;
    float* Qf = Vf + 132 * 64;
    float* Sc = Qf + 16 * 64;
    const bf16_t* QKV = (const bf16_t*)(p->ws + WS_QKV); const float* rope = (const float*)(p->ws + WS_ROPE);
    bf16_t* Z = (bf16_t*)(p->ws + WS_Z);
    const int tid = tidx();
    __syncthreads();
    for (int i = tid; i < 128 * 16; i += 512) { const int key = i >> 4, d4 = (i & 15) * 4; const size_t off = ((size_t)(bs * 128 + key) * 2 + kvh) * 64 + d4;
        const float4 k = *(const float4*)(p->in[I_CK] + off), v = *(const float4*)(p->in[I_CV] + off);
        float* kd = Kf + key * 65 + d4; kd[0] = k.x; kd[1] = k.y; kd[2] = k.z; kd[3] = k.w; *(float4*)(Vf + key * 64 + d4) = v;
        if (key >= 4) { const size_t oo = ((size_t)(bs * 128 + key - 4) * 2 + kvh) * 64 + d4; *(float4*)(p->out + O_KWS + oo) = k; *(float4*)(p->out + O_VWS + oo) = v; } }
    if (tid < 256) { const int t = tid >> 6, d = tid & 63; const int tok = TP + bs * 4 + t; const bf16_t* src = QKV + (size_t)tok * 768;
        float kx = bf1(src[512 + kvh * 64 + d]); const float vx = bf1(src[640 + kvh * 64 + d]);
        if (d < 16) { const float* rt = rope + (2048 + t) * 16; const float other = bf1(src[512 + kvh * 64 + (d ^ 8)]); const int f = d & 7;
            kx = d < 8 ? kx * rt[f] - other * rt[8 + f] : kx * rt[f] + other * rt[8 + f]; }
        Kf[(128 + t) * 65 + d] = kx; Vf[(128 + t) * 64 + d] = vx;
        const size_t oo = ((size_t)(bs * 128 + 124 + t) * 2 + kvh) * 64 + d; p->out[O_KWS + oo] = kx; p->out[O_VWS + oo] = vx; }
    for (int i = tid; i < 1024; i += 512) { const int row = i >> 6, d = i & 63, g = row >> 2, t = row & 3; const int tok = TP + bs * 4 + t;
        const bf16_t* src = QKV + (size_t)tok * 768 + (kvh * 4 + g) * 64;
        float qx = bf1(src[d]);
        if (d < 16) { const float* rt = rope + (2048 + t) * 16; const float other = bf1(src[d ^ 8]); const int f = d & 7;
            qx = d < 8 ? qx * rt[f] - other * rt[8 + f] : qx * rt[f] + other * rt[8 + f]; }
        Qf[row * 64 + d] = qx; }
    __syncthreads();
    for (int i = tid; i < 16 * 132; i += 512) { const int row = i / 132, key = i - row * 132, t = row & 3;
        const bool ok = key < 128 ? (key > t) : (key - 128 <= t);
        float a = 0.f;
#pragma unroll 8
        for (int d = 0; d < 64; ++d) a += Qf[row * 64 + d] * Kf[key * 65 + d];
        Sc[row * 136 + key] = ok ? a * 0.125f : -INFINITY; }
    __syncthreads();
    { const int w = tid >> 6, l = tid & 63;
#pragma unroll
        for (int rr = 0; rr < 2; ++rr) { const int row = w * 2 + rr; const float sink = p->in[I_SINK][kvh * 4 + (row >> 2)];
            float v0 = Sc[row * 136 + l], v1 = Sc[row * 136 + 64 + l], v2 = (l < 4) ? Sc[row * 136 + 128 + l] : -INFINITY;
            float m = fmaxf(fmaxf(v0, v1), fmaxf(v2, sink));
#pragma unroll
            for (int o = 32; o > 0; o >>= 1) m = fmaxf(m, __shfl_xor(m, o));
            v0 = __expf(v0 - m); v1 = __expf(v1 - m); v2 = __expf(v2 - m);
            const float sum = wave_sum(v0 + v1 + v2) + __expf(sink - m); const float rinv = 1.f / sum;
            Sc[row * 136 + l] = v0 * rinv; Sc[row * 136 + 64 + l] = v1 * rinv; if (l < 4) Sc[row * 136 + 128 + l] = v2 * rinv; } }
    __syncthreads();
    { const int row = tid >> 5, d = (tid & 31) * 2, g = row >> 2, t = row & 3; float a0 = 0.f, a1 = 0.f;
        for (int key = 0; key < 132; ++key) { const float pr = Sc[row * 136 + key]; a0 += pr * Vf[key * 64 + d]; a1 += pr * Vf[key * 64 + d + 1]; }
        const int tok = TP + bs * 4 + t;
        *(unsigned*)(Z + (size_t)tok * 1024 + (kvh * 4 + g) * 64 + d) = cvt_pk_bf16(a0, a1); }
}

__device__ void gates_item(KP p, unsigned char* lds, int tile) {
    float* xcs = (float*)lds;
    const int c = tidx(), t0 = tile * 32;
    const float* XR = (const float*)(p->ws + WS_XGR) + 512;
    float* LA = (float*)(p->ws + WS_LA); float* LB = (float*)(p->ws + WS_LB);
    const float cw0 = p->in[I_CONVW][c], cw1 = p->in[I_CONVW][512 + c], cw2 = p->in[I_CONVW][1024 + c], cw3 = p->in[I_CONVW][1536 + c], cb = p->in[I_CONVB][c];
    __syncthreads();
    if (t0 < TP) {
        const int b = t0 >> 11, tau0 = t0 & 2047;
        float xm3 = 0.f, xm2 = 0.f, xm1 = 0.f;
        if (tau0 > 0) { xm3 = XR[(size_t)(t0 - 3) * 1024 + c]; xm2 = XR[(size_t)(t0 - 2) * 1024 + c]; xm1 = XR[(size_t)(t0 - 1) * 1024 + c]; }
#pragma unroll 8
        for (int i = 0; i < 32; ++i) { const float x = XR[(size_t)(t0 + i) * 1024 + c];
            xcs[i * 512 + c] = cb + cw0 * xm3 + cw1 * xm2 + cw2 * xm1 + cw3 * x; xm3 = xm2; xm2 = xm1; xm1 = x; }
        if (tau0 + 32 == 2048) { float* co = p->out + O_CONVP + (size_t)b * 3 * 512 + c; co[0] = xm3; co[512] = xm2; co[1024] = xm1; }
    } else {
#pragma unroll 1
        for (int s = 0; s < 8; ++s) { const int bs = ((t0 - TP) >> 2) + s; const float* cs = p->in[I_SCONV] + (size_t)bs * 3 * 512 + c;
            float xm3 = cs[0], xm2 = cs[512], xm1 = cs[1024];
#pragma unroll
            for (int i = 0; i < 4; ++i) { const float x = XR[(size_t)(t0 + s * 4 + i) * 1024 + c];
                xcs[(s * 4 + i) * 512 + c] = cb + cw0 * xm3 + cw1 * xm2 + cw2 * xm1 + cw3 * x; xm3 = xm2; xm2 = xm1; xm1 = x; }
            float* co = p->out + O_CONVS + (size_t)bs * 3 * 512 + c; co[0] = xm3; co[512] = xm2; co[1024] = xm1; }
    }
    __syncthreads();
    const int k = c >> 6, e = c & 63;
    float* rs = xcs + 32 * 512;
    const float lam = p->in[I_LAM][c]; const float sp = log1pf(__expf(-lam));
#pragma unroll 1
    for (int gsel = 0; gsel < 2; ++gsel) {
        const float* W = p->in[gsel ? I_WX : I_WA] + (size_t)(k * 64) * 64 + e;
        float wr_[64];
#pragma unroll
        for (int d = 0; d < 64; ++d) wr_[d] = W[d * 64];
        const float bias = p->in[gsel ? I_BX : I_BA][c];
#pragma unroll 1
        for (int t = 0; t < 32; ++t) {
            float a0 = bias, a1 = 0.f; const float* xr = xcs + t * 512 + k * 64;
#pragma unroll
            for (int d4 = 0; d4 < 16; d4 += 2) { const float4 x = *(const float4*)(xr + d4 * 4), y = *(const float4*)(xr + d4 * 4 + 4);
                a0 += x.x * wr_[d4 * 4] + x.y * wr_[d4 * 4 + 1] + x.z * wr_[d4 * 4 + 2] + x.w * wr_[d4 * 4 + 3];
                a1 += y.x * wr_[d4 * 4 + 4] + y.y * wr_[d4 * 4 + 5] + y.z * wr_[d4 * 4 + 6] + y.w * wr_[d4 * 4 + 7]; }
            const float sg = sigmoidf_(a0 + a1);
            if (gsel == 0) rs[t * 512 + c] = sg;
            else { const float r = rs[t * 512 + c];
                const float log_a = -8.0f * r * sp; const float a = __expf(log_a);
                const float mult = sqrtf(fmaxf(1.0f - __expf(2.0f * log_a), 0.0f));
                const float xc = xcs[t * 512 + c];
                LA[(size_t)(t0 + t) * 512 + c] = a; LB[(size_t)(t0 + t) * 512 + c] = mult * (sg * xc); }
        }
    }
}

__device__ void phase_mix_a(KP p, unsigned char* lds) {
#ifndef NO_AP
    for (int it = blockIdx.x; it < 256; it += gridDim.x) attn_prompt_item(p, lds, it);
#endif
#ifndef NO_AS
    for (int it = blockIdx.x; it < 256; it += gridDim.x) attn_sample_item(p, lds, it);
#endif
#ifndef NO_GT
    for (int it = blockIdx.x; it < 528; it += gridDim.x) gates_item(p, lds, it);
#endif
}

__device__ __forceinline__ float gelu_tanh(float x) { const float u = 0.7978845608028654f * (x + 0.044715f * x * x * x); return 0.5f * x * (1.f + tanhf(u)); }
__device__ void phase_mix_b(KP p, unsigned char* lds) {
    const float* LA = (const float*)(p->ws + WS_LA); const float* LB = (const float*)(p->ws + WS_LB);
    const float* XG = (const float*)(p->ws + WS_XGR); bf16_t* Z = (bf16_t*)(p->ws + WS_Z);
    float* sA = (float*)lds; float* sB = sA + 512;
    const int tid = tidx();
    for (int it = blockIdx.x; it < 256 + 128; it += gridDim.x) {
        if (it < 256) {
            const int b = it >> 5, c = (it & 31) * 16 + (tid & 15), ch = tid >> 4;
            const size_t base = (size_t)(b * 2048 + ch * 64);
            float A = 1.f, B = 0.f;
#pragma unroll 8
            for (int i = 0; i < 64; ++i) { const float a = LA[(base + i) * 512 + c], bb = LB[(base + i) * 512 + c]; B = a * B + bb; A *= a; }
            __syncthreads();
            sA[tid] = A; sB[tid] = B;
            __syncthreads();
            float h = 0.f;
            for (int j = 0; j < ch; ++j) h = sA[j * 16 + (tid & 15)] * h + sB[j * 16 + (tid & 15)];
#pragma unroll 8
            for (int i = 0; i < 64; ++i) { const float a = LA[(base + i) * 512 + c], bb = LB[(base + i) * 512 + c]; h = a * h + bb;
                const float g = gelu_tanh(XG[(base + i) * 1024 + c]); Z[(base + i) * 1024 + 512 + c] = f2bf(g * h); }
            if (ch == 31) p->out[O_HP + b * 512 + c] = h;
        } else {
            const int bs = it - 256, c = tid; float h = p->in[I_SH][bs * 512 + c];
#pragma unroll
            for (int i = 0; i < 4; ++i) { const size_t tok = TP + bs * 4 + i; h = LA[tok * 512 + c] * h + LB[tok * 512 + c];
                const float g = gelu_tanh(XG[tok * 1024 + c]); Z[tok * 1024 + 512 + c] = f2bf(g * h); }
            p->out[O_HS + bs * 512 + c] = h;
        }
    }
}

__device__ void hgrn_item(KP p, unsigned char* lds, int tok0, int ntok, const float* s0, float* sout, int h, int vs) {
    float* qs = (float*)lds;
    float* fs = qs + 32 * 128;
    float* vsm = fs + 32 * 128;
    float* op = vsm + 32 * 32;
    const bf16_t* QF = (const bf16_t*)(p->ws + WS_QFVG); bf16_t* Z = (bf16_t*)(p->ws + WS_Z);
    const int tid = tidx(), v = tid & 31, kg = tid >> 5;
    float S[8];
#pragma unroll
    for (int i = 0; i < 8; ++i) S[i] = s0 ? s0[(size_t)(kg * 8 + i) * 128 + vs * 32 + v] : 0.f;
    const int ks = tid & 127; const float l0 = p->in[I_LB][h * 128 + ks], l1 = p->in[I_LB][1024 + h * 128 + ks];
    const float lb = 1.f / (1.f + __expf(l0 - l1));
    for (int t0 = 0; t0 < ntok; t0 += 32) {
        const int nb = (ntok - t0) < 32 ? (ntok - t0) : 32;
        __syncthreads();
        for (int i = tid; i < nb * 128; i += 512) { const int t = i >> 7; const bf16_t* src = QF + (size_t)(tok0 + t0 + t) * 4096 + h * 128 + ks;
            qs[t * 128 + ks] = bf1(src[0]); fs[t * 128 + ks] = lb + (1.f - lb) * sigmoidf_(bf1(src[1024])); }
        for (int i = tid; i < nb * 32; i += 512) { const int t = i >> 5, vv = i & 31; vsm[t * 32 + vv] = bf1(QF[(size_t)(tok0 + t0 + t) * 4096 + 2048 + h * 128 + vs * 32 + vv]); }
        __syncthreads();
        for (int t = 0; t < nb; ++t) {
            const float4 f0 = *(const float4*)(fs + t * 128 + kg * 8), f1 = *(const float4*)(fs + t * 128 + kg * 8 + 4);
            const float4 q0 = *(const float4*)(qs + t * 128 + kg * 8), q1 = *(const float4*)(qs + t * 128 + kg * 8 + 4);
            const float vv = vsm[t * 32 + v];
            const float f[8] = {f0.x, f0.y, f0.z, f0.w, f1.x, f1.y, f1.z, f1.w}, q[8] = {q0.x, q0.y, q0.z, q0.w, q1.x, q1.y, q1.z, q1.w};
            float o = 0.f;
#pragma unroll
            for (int i = 0; i < 8; ++i) { S[i] = f[i] * S[i] + (1.f - f[i]) * vv; o += q[i] * S[i]; }
            op[(kg * 32 + t) * 32 + v] = o;
        }
        __syncthreads();
        for (int i = tid; i < nb * 32; i += 512) { const int t = i >> 5, vv = i & 31; float o = 0.f;
#pragma unroll
            for (int g = 0; g < 16; ++g) o += op[(g * 32 + t) * 32 + vv];
            Z[(size_t)(tok0 + t0 + t) * 1024 + h * 128 + vs * 32 + vv] = f2bf(o); }
    }
#pragma unroll
    for (int i = 0; i < 8; ++i) sout[(size_t)(kg * 8 + i) * 128 + vs * 32 + v] = S[i];
}

__device__ void hgrn_prompt_item(KP p, unsigned char* lds, int b, int h, int vs) {
    const int tid = tidx(), w = tid >> 6, l = tid & 63, fr = l & 15, fq = l >> 4;
    constexpr int QD_B = 32 * 136 * 2, KLT_B = 128 * 40 * 2, VT_B = 32 * 40 * 2, BUF_B = 2 * QD_B + KLT_B + VT_B + 512;
    unsigned char* st_base = lds + 2 * BUF_B;
    const bf16_t* QF = (const bf16_t*)(p->ws + WS_QFVG); bf16_t* Z = (bf16_t*)(p->ws + WS_Z);
    const int tok0 = b * 2048;
    const int k = 16 * w + fr;
    const float l0 = p->in[I_LB][h * 128 + k], l1 = p->in[I_LB][1024 + h * 128 + k];
    const float lb = 1.f / (1.f + __expf(l0 - l1));
    const bf16_t* qsrc = QF + (size_t)(tok0 + 8 * fq) * 4096 + h * 128 + k;
    const int tv = tid >> 4, vp = (tid & 15) * 2;
    const bf16_t* vsrc = QF + (size_t)(tok0 + tv) * 4096 + 2048 + h * 128 + vs * 32 + vp;
    __syncthreads();
    for (int i = tid; i < 32 * 136 / 2; i += 512) ((unsigned*)st_base)[i] = 0u;
    f32x4 S[2] = {(f32x4){0.f, 0.f, 0.f, 0.f}, (f32x4){0.f, 0.f, 0.f, 0.f}};
    unsigned nq[8], nf[8], nv;
#pragma unroll
    for (int i = 0; i < 8; ++i) { nq[i] = qsrc[(size_t)i * 4096]; nf[i] = qsrc[(size_t)i * 4096 + 1024]; }
    nv = *(const unsigned*)vsrc;
#pragma unroll 1
    for (int step = 0; step < 64; ++step) {
        const int pb = step & 1;
        unsigned char* buf = lds + pb * BUF_B;
        bf16_t* Qd = (bf16_t*)buf; bf16_t* Kd = Qd + 32 * 136; bf16_t* KlT = Kd + 32 * 136; bf16_t* VT = KlT + 128 * 40; float* dl = (float*)(VT + 32 * 40);
        unsigned cq[8], cf[8]; const unsigned cv = nv;
#pragma unroll
        for (int i = 0; i < 8; ++i) { cq[i] = nq[i]; cf[i] = nf[i]; }
        if (step + 1 < 64) { const size_t adv = (size_t)(step + 1) * 32 * 4096;
#pragma unroll
            for (int i = 0; i < 8; ++i) { nq[i] = qsrc[adv + (size_t)i * 4096]; nf[i] = qsrc[adv + (size_t)i * 4096 + 1024]; }
            nv = *(const unsigned*)(vsrc + adv); }
        float q[8], kk[8], bb[8]; float run = 0.f;
#pragma unroll
        for (int i = 0; i < 8; ++i) { const float f = lb + (1.f - lb) * sigmoidf_(bf1((bf16_t)cf[i])); kk[i] = 1.f - f; run += __logf(f); bb[i] = run; q[i] = bf1((bf16_t)cq[i]); }
        float off = 0.f;
#pragma unroll
        for (int g = 1; g < 4; ++g) { const float v = __shfl(run, (l - 16 * g) & 63); off += (fq >= g) ? v : 0.f; }
#pragma unroll
        for (int i = 0; i < 8; ++i) bb[i] += off;
        const float bL = __shfl(bb[7], 48 + fr);
        float kl[8];
#pragma unroll
        for (int i = 0; i < 8; ++i) { const int t = 8 * fq + i;
            Qd[t * 136 + k] = f2bf(q[i] * __expf(bb[i])); Kd[t * 136 + k] = f2bf(kk[i] * __expf(-bb[i])); kl[i] = kk[i] * __expf(bL - bb[i]); }
        { u32x4 pk; pk.x = cvt_pk_bf16(kl[0], kl[1]); pk.y = cvt_pk_bf16(kl[2], kl[3]); pk.z = cvt_pk_bf16(kl[4], kl[5]); pk.w = cvt_pk_bf16(kl[6], kl[7]);
            *(u32x4*)(KlT + k * 40 + 8 * fq) = pk; }
        if (fq == 0) dl[k] = __expf(bL);
        VT[vp * 40 + tv] = (bf16_t)(cv & 0xffffu); VT[(vp + 1) * 40 + tv] = (bf16_t)(cv >> 16);
        __syncthreads();
        const bf16_t* STc = (const bf16_t*)(st_base + pb * QD_B); bf16_t* STn = (bf16_t*)(st_base + (pb ^ 1) * QD_B);
        if (w < 4) {
            const int vt = w & 1, tt = w >> 1;
            bf16x8 qf[4];
#pragma unroll
            for (int ks = 0; ks < 4; ++ks) qf[ks] = *(const bf16x8*)(Qd + (16 * tt + fr) * 136 + 32 * ks + 8 * fq);
            f32x4 sc0 = {0.f, 0.f, 0.f, 0.f}, sc1 = {0.f, 0.f, 0.f, 0.f};
#pragma unroll
            for (int ks = 0; ks < 4; ++ks) sc0 = __builtin_amdgcn_mfma_f32_16x16x32_bf16(*(const bf16x8*)(Kd + fr * 136 + 32 * ks + 8 * fq), qf[ks], sc0, 0, 0, 0);
            if (tt == 1) {
#pragma unroll
                for (int ks = 0; ks < 4; ++ks) sc1 = __builtin_amdgcn_mfma_f32_16x16x32_bf16(*(const bf16x8*)(Kd + (16 + fr) * 136 + 32 * ks + 8 * fq), qf[ks], sc1, 0, 0, 0); }
            const int tq = 16 * tt + fr;
#pragma unroll
            for (int r = 0; r < 4; ++r) { if (4 * fq + r > tq) sc0[r] = 0.f; if (16 + 4 * fq + r > tq) sc1[r] = 0.f; }
            u32x4 pt; pt.x = cvt_pk_bf16(sc0[0], sc0[1]); pt.y = cvt_pk_bf16(sc0[2], sc0[3]); pt.z = cvt_pk_bf16(sc1[0], sc1[1]); pt.w = cvt_pk_bf16(sc1[2], sc1[3]);
            const bf16_t* vrow = VT + (16 * vt + fr) * 40;
            u32x4 vv; { const u32x2 lo = *(const u32x2*)(vrow + 4 * fq), hi = *(const u32x2*)(vrow + 16 + 4 * fq); vv.x = lo.x; vv.y = lo.y; vv.z = hi.x; vv.w = hi.y; }
            f32x4 o = {0.f, 0.f, 0.f, 0.f};
            o = __builtin_amdgcn_mfma_f32_16x16x32_bf16(__builtin_bit_cast(bf16x8, vv), __builtin_bit_cast(bf16x8, pt), o, 0, 0, 0);
#pragma unroll
            for (int ks = 0; ks < 4; ++ks) o = __builtin_amdgcn_mfma_f32_16x16x32_bf16(*(const bf16x8*)(STc + (16 * vt + fr) * 136 + 32 * ks + 8 * fq), qf[ks], o, 0, 0, 0);
            u32x2 wv; wv.x = cvt_pk_bf16(o[0], o[1]); wv.y = cvt_pk_bf16(o[2], o[3]);
            *(u32x2*)(Z + (size_t)(tok0 + step * 32 + tq) * 1024 + h * 128 + vs * 32 + 16 * vt + 4 * fq) = wv;
        }
        { const float4 d4 = *(const float4*)(dl + 16 * w + 4 * fq); const bf16x8 klf = *(const bf16x8*)(KlT + (16 * w + fr) * 40 + 8 * fq);
#pragma unroll
            for (int vt = 0; vt < 2; ++vt) { f32x4 a = S[vt]; a[0] *= d4.x; a[1] *= d4.y; a[2] *= d4.z; a[3] *= d4.w;
                a = __builtin_amdgcn_mfma_f32_16x16x32_bf16(klf, *(const bf16x8*)(VT + (16 * vt + fr) * 40 + 8 * fq), a, 0, 0, 0); S[vt] = a;
                u32x2 sv; sv.x = cvt_pk_bf16(a[0], a[1]); sv.y = cvt_pk_bf16(a[2], a[3]);
                *(u32x2*)(STn + (16 * vt + fr) * 136 + 16 * w + 4 * fq) = sv; } }
    }
    float* so = p->out + O_SP + (size_t)(b * 8 + h) * 16384;
#pragma unroll
    for (int vt = 0; vt < 2; ++vt)
#pragma unroll
        for (int r = 0; r < 4; ++r) so[(size_t)(16 * w + 4 * fq + r) * 128 + vs * 32 + 16 * vt + fr] = S[vt][r];
}
__device__ void phase_hgrn(KP p, unsigned char* lds) {
    for (int it = blockIdx.x; it < 256; it += gridDim.x) { const int b = it >> 5, h = (it >> 2) & 7, vs = it & 3;
        hgrn_prompt_item(p, lds, b, h, vs); }
    for (int it = blockIdx.x; it < 4096; it += gridDim.x) { const int bs = it >> 5, h = (it >> 2) & 7, vs = it & 3;
        hgrn_item(p, lds, TP + bs * 4, 4, p->in[I_SS] + (size_t)(bs * 8 + h) * 16384, p->out + O_SS + (size_t)(bs * 8 + h) * 16384, h, vs); }
}
__device__ void phase_znorm(KP p) {
    const int lane = tidx() & 63, wave = tidx() >> 6;
    bf16_t* Z = (bf16_t*)(p->ws + WS_Z); const bf16_t* QF = (const bf16_t*)(p->ws + WS_QFVG);
    float gn[16];
#pragma unroll
    for (int i = 0; i < 16; ++i) gn[i] = p->in[I_GN][(lane & 7) * 16 + i];
    for (int row = blockIdx.x * 8 + wave; row < TT; row += gridDim.x * 8) {
        bf16_t* zp = Z + (size_t)row * 1024 + lane * 16; const bf16_t* gp = QF + (size_t)row * 4096 + 3072 + lane * 16;
        const u32x4 a = *(const u32x4*)zp, b2 = *(const u32x4*)(zp + 8), ga = *(const u32x4*)gp, gb = *(const u32x4*)(gp + 8);
        const unsigned ow[8] = {a.x, a.y, a.z, a.w, b2.x, b2.y, b2.z, b2.w}, gw[8] = {ga.x, ga.y, ga.z, ga.w, gb.x, gb.y, gb.z, gb.w};
        float o[16], g[16]; float ss = 0.f;
#pragma unroll
        for (int i = 0; i < 8; ++i) { o[2 * i] = bf_lo(ow[i]); o[2 * i + 1] = bf_hi(ow[i]); g[2 * i] = bf_lo(gw[i]); g[2 * i + 1] = bf_hi(gw[i]); ss += o[2 * i] * o[2 * i] + o[2 * i + 1] * o[2 * i + 1]; }
        ss += __shfl_xor(ss, 1); ss += __shfl_xor(ss, 2); ss += __shfl_xor(ss, 4);
        const float inv = rsqrtf(ss * (1.0f / 128.0f) + 1e-6f);
        unsigned w[8];
#pragma unroll
        for (int i = 0; i < 8; ++i) w[i] = cvt_pk_bf16((o[2 * i] * inv) * gn[2 * i] * siluf_(g[2 * i]), (o[2 * i + 1] * inv) * gn[2 * i + 1] * siluf_(g[2 * i + 1]));
        *(u32x4*)zp = (u32x4){w[0], w[1], w[2], w[3]}; *(u32x4*)(zp + 8) = (u32x4){w[4], w[5], w[6], w[7]};
    }
}

template <class Epi> __device__ __forceinline__ void run_gemm(unsigned char* lds, const bf16_t* A, const bf16_t* Bt, int M, int N, int K, const Epi& E, int split) {
    pg8::Gemm g; g.A = A; g.Bt = Bt; g.M = M; g.N = N; g.K = K;
    pg8::StaticOrder S; S.init(M, N, (int)gridDim.x, (int)blockIdx.x, K, split);
    pg8::gemm_phase<Epi, pg8::StaticOrder, false>((PG8_LAS unsigned char*)lds, g, S, E, nullptr);
}
constexpr int N_PHASES = 25;
#ifndef PH_MASK
#define PH_MASK 0xffffffffu
#endif
#define PHX(k, call) do { if constexpr ((PH_MASK >> (k)) & 1u) { call; } } while (0)
__global__ __launch_bounds__(512, 2) void hybrid_fwd(Params p_arg) {
    extern __shared__ __attribute__((aligned(16))) unsigned char shm[];
    cg::grid_group grid = cg::this_grid();
    volatile LAS unsigned* xst = (volatile LAS unsigned*)(shm + LDS_BYTES - 16);
    unsigned* xbar = (unsigned*)(p_arg.ws + WS_BAR);
    if (tidx() == 0) { xst[0] = 0u; xst[1] = 0u; }
    if (blockIdx.x == 0) for (int i = tidx(); i < XCD_BAR_WORDS; i += 512) xbar[i] = 0u;
    XcdBarrier xb; xb.bar = xbar; xb.x = 0u; xb.st = xst;
    const int ph_lo = p_arg.ph_lo, ph_hi = p_arg.ph_hi;
    for (int ph = ph_lo; ph < ph_hi; ++ph) {
        KP p = (KP)__builtin_amdgcn_kernarg_segment_ptr(); asm volatile("" : "+s"(p));
        unsigned char* ws = p->ws;
        int kind, arg = 0;
        switch (ph) {
            case 0: kind = 0; break;            case 1: kind = 1; break;
            case 2: kind = 2; arg = 0; break;   case 3: kind = 3; arg = 0; break;   case 4: kind = 4; arg = 0; break;
            case 5: kind = 2; arg = 1; break;   case 6: kind = 5; break;            case 7: kind = 6; break;   case 8: kind = 7; break;   case 9: kind = 8; break;
            case 10: kind = 2; arg = 2; break;  case 11: kind = 3; arg = 1; break;  case 12: kind = 4; arg = 1; break;
            case 13: kind = 2; arg = 3; break;  case 14: kind = 3; arg = 2; break;  case 15: kind = 4; arg = 2; break;
            case 16: kind = 2; arg = 4; break;  case 17: kind = 9; break;           case 18: kind = 10; break;  case 19: kind = 11; break;  case 20: kind = 12; break;
            case 21: kind = 2; arg = 5; break;  case 22: kind = 3; arg = 3; break;  case 23: kind = 4; arg = 3; break;
            default: kind = 2; arg = 6; break;
        }
        const bf16_t* gA = nullptr; const bf16_t* gB = nullptr; int gM = TT, gN = 1024, gK = 1024; EpiAny ge{0, nullptr, nullptr, 1024, nullptr}; int gsplit = 0;
        if (kind == 1) { gA = (const bf16_t*)(ws + WS_AADA); gB = (const bf16_t*)(ws + WS_ADA); gM = 256; gN = NMOD; ge = EpiAny{0, ws + WS_MOD, nullptr, NMOD, p->in[I_ADAB]}; }
        else if (kind == 3) { gA = (const bf16_t*)(ws + WS_H); gB = (const bf16_t*)(ws + WS_FIN + (size_t)arg * SZ_FIN); gN = 5632; ge = EpiAny{1, ws + WS_A2, nullptr, 2816, nullptr}; }
        else if (kind == 4) { gA = (const bf16_t*)(ws + WS_A2); gB = (const bf16_t*)(ws + WS_FOUT + (size_t)arg * SZ_FOUT); gK = 2816; gsplit = 11; ge = EpiAny{4, ws + WS_Y, ws + WS_SLAB, 1024, nullptr}; }
        else if (kind == 8) { gA = (const bf16_t*)(ws + WS_Z); gB = (const bf16_t*)(ws + WS_EOUT); gsplit = 4; ge = EpiAny{4, ws + WS_Y, ws + WS_SLAB, 1024, nullptr}; }
        else if (kind == 12) { gA = (const bf16_t*)(ws + WS_Z); gB = (const bf16_t*)(ws + WS_OOUT); gsplit = 4; ge = EpiAny{4, ws + WS_Y, ws + WS_SLAB, 1024, nullptr}; }
        else if (kind == 5) { gA = (const bf16_t*)(ws + WS_H); gB = (const bf16_t*)(ws + WS_EIN); gN = 1792; ge = EpiAny{3, ws + WS_QKV, ws + WS_XGR, 768, nullptr}; }
        else if (kind == 9) { gA = (const bf16_t*)(ws + WS_H); gB = (const bf16_t*)(ws + WS_OIN); gN = 4096; ge = EpiAny{2, ws + WS_QFVG, nullptr, 4096, nullptr}; }
#ifndef PH_REP
#define PH_REP 0u
#endif
        const int nrep = ((PH_REP >> ph) & 1u) ? 2 : 1;
        for (int rep = 0; rep < nrep; ++rep) {
        if (gA) { PHX(1, run_gemm(shm, gA, gB, gM, gN, gK, ge, gsplit)); }
        else if (kind == 0) { PHX(0, phase_convert(p, shm)); }
        else if (kind == 2) { PHX(2, phase_rowop(p, arg)); }
        else if (kind == 6) { PHX(6, phase_mix_a(p, shm)); }
        else if (kind == 7) { PHX(7, phase_mix_b(p, shm)); }
        else if (kind == 10) { PHX(10, phase_hgrn(p, shm)); }
        else if (kind == 11) { PHX(11, phase_znorm(p)); }
        }
        if (ph + 1 < ph_hi) {
            if (ph == ph_lo) { grid.sync(); xb = xcd_barrier_post(xbar, xst); }
            else xcd_barrier(xb);
        }
    }
}

extern "C" void kernel_launch(void* const* d_in, const int* in_sizes, int n_in, void* d_out, int out_size, void* d_ws, size_t ws_size, hipStream_t stream) {
    static int grid = 0;
    if (grid == 0) {
        if (n_in != N_INPUTS || out_size != 39862272 || ws_size < WS_END) { fprintf(stderr, "kernel_launch: unexpected shapes: n_in %d out %d ws %zu (need %zu)\n", n_in, out_size, ws_size, (size_t)WS_END); grid = -1; return; }
        int dev = 0, cus = 0, per_cu = 0;
        hipGetDevice(&dev); hipDeviceGetAttribute(&cus, hipDeviceAttributeMultiprocessorCount, dev);
        if (hipFuncSetAttribute((const void*)hybrid_fwd, hipFuncAttributeMaxDynamicSharedMemorySize, LDS_BYTES) != hipSuccess) { fprintf(stderr, "kernel_launch: hipFuncSetAttribute failed\n"); grid = -1; return; }
        hipOccupancyMaxActiveBlocksPerMultiprocessor(&per_cu, (const void*)hybrid_fwd, 512, LDS_BYTES);
        (void)hipGetLastError();
        if (per_cu < 1) per_cu = 1;
        grid = cus;
        fprintf(stderr, "kernel_launch: cus %d per_cu %d grid %d ws %zu\n", cus, per_cu, grid, ws_size);
    }
    if (grid < 0) return;
    Params p{};
    for (int i = 0; i < N_INPUTS; ++i) p.in[i] = (const float*)d_in[i];
    p.out = (float*)d_out; p.ws = (unsigned char*)d_ws; p.ph_lo = 0; p.ph_hi = N_PHASES;
    void* args[] = {&p};
    hipError_t e = hipLaunchCooperativeKernel((const void*)hybrid_fwd, dim3(grid), dim3(512), args, LDS_BYTES, stream);
    if (e != hipSuccess) fprintf(stderr, "cooperative launch failed: %s (grid %d)\n", hipGetErrorString(e), grid);
}
```
